# Optimizing an MI355X kernel written in HIP

```python
import math
import jax, jax.numpy as jnp
from jax import lax
import numpy as np

D_MODEL = 1024
BATCH = 16
SEQ = 256
DEPTH = 2
DEC_BATCH = 4
DEC_SEQ = 2048
PAST_LEN = 256

GRID_W = 64
N_MIXERS = 2
N_ATTN_LAYERS = (DEPTH + 1) // 2
N_HGRN_LAYERS = DEPTH // 2
N_MOD = 9
EPS = 1e-6
DA_HEADS = D_MODEL // 128
DA_DK = 64
DA_DV = 128
ROPE_THETA = 10000.0
Q_BLOCK = 128
HG_HEADS = D_MODEL // 128
HG_DK = 128
HG_DV = D_MODEL // HG_HEADS
CHUNK = 32
FFN_HIDDEN = ((8 * D_MODEL // 3 + 127) // 128) * 128

kernel_name = "diff_hgrn2_macaron_prefix_dit"


def rmsnorm(x, g):
    xf = x.astype(jnp.float32)
    y = xf * lax.rsqrt(jnp.mean(xf * xf, axis=-1, keepdims=True) + EPS)
    return (y * g.astype(jnp.float32)).astype(x.dtype)


def ada_pre(x, mod, j, g):
    shift = mod[:, 3 * j][:, None, :]
    scale = mod[:, 3 * j + 1][:, None, :]
    return rmsnorm(x, g) * (1 + scale) + shift


def ada_post(x, y, mod, j, g, res_w):
    gate = mod[:, 3 * j + 2][:, None, :]
    return x + res_w * gate * rmsnorm(y, g)


def swiglu(h, w_in, w_out):
    a, b = jnp.split(h @ w_in, 2, axis=-1)
    return (jax.nn.silu(a) * b) @ w_out


def ffn_sublayer(x, mod, j, g_pre, g_post, w_in, w_out):
    return ada_post(x, swiglu(ada_pre(x, mod, j, g_pre), w_in, w_out), mod, j, g_post, 0.5)


def axial_rope(x):
    L = x.shape[1]
    rows = L // GRID_W
    row = jnp.repeat(jnp.arange(rows, dtype=jnp.float32), GRID_W)
    col = jnp.tile(jnp.arange(GRID_W, dtype=jnp.float32), rows)
    nf = DA_DK // 4
    inv = ROPE_THETA ** (-jnp.arange(nf, dtype=jnp.float32) / nf)
    ang = jnp.stack([row[:, None] * inv, col[:, None] * inv], axis=1)
    cos = jnp.cos(ang)[None, :, None, None]
    sin = jnp.sin(ang)[None, :, None, None]
    xr = x.astype(jnp.float32).reshape(*x.shape[:-1], 2, 2, nf)
    x1 = xr[..., 0, :]
    x2 = xr[..., 1, :]
    out = jnp.stack([x1 * cos - x2 * sin, x1 * sin + x2 * cos], axis=-2)
    return out.reshape(x.shape).astype(x.dtype)


def diff_qkv(h, w_in):
    B, L, _ = h.shape
    z = h @ w_in
    qd = DA_HEADS * 2 * DA_DK
    q = z[..., :qd].reshape(B, L, DA_HEADS, 2, DA_DK)
    k = z[..., qd:2 * qd].reshape(B, L, DA_HEADS, 2, DA_DK)
    v = z[..., 2 * qd:].reshape(B, L, DA_HEADS, DA_DV)
    return q, k, v


def diff_lambda(lam_p, lam_init):
    lp = lam_p.astype(jnp.float32)
    return jnp.exp(jnp.sum(lp[0] * lp[1])) - jnp.exp(jnp.sum(lp[2] * lp[3])) + lam_init


def diff_attention(q, k, v, lam):
    B, Lq = q.shape[:2]
    nb = Lq // Q_BLOCK
    qb = q.reshape(B, nb, Q_BLOCK, DA_HEADS, 2, DA_DK).transpose(1, 0, 2, 3, 4, 5)
    kf = k.astype(jnp.float32)
    vf = v.astype(jnp.float32)
    scale = DA_DK ** -0.5

    def block(qi):
        s = jnp.einsum('bqhcd,bkhcd->bhcqk', qi.astype(jnp.float32), kf) * scale
        p = jax.nn.softmax(s, axis=-1)
        a = p[:, :, 0] - lam * p[:, :, 1]
        return jnp.einsum('bhqk,bkhv->bqhv', a, vf)

    o = lax.map(block, qb)
    return o.transpose(1, 0, 2, 3, 4).reshape(B, Lq, DA_HEADS, DA_DV)


def diff_out(o, lam_init, gain, w_out, dtype):
    B, L = o.shape[:2]
    o = rmsnorm(o, gain) * (1 - lam_init)
    return o.reshape(B, L, DA_HEADS * DA_DV).astype(dtype) @ w_out


def hgrn_proj(h, w_in, lb):
    B, L, _ = h.shape
    z = (h @ w_in).astype(jnp.float32)
    q, ff, fb, i, g = [a.reshape(B, L, HG_HEADS, -1) for a in jnp.split(z, 5, axis=-1)]
    f_f = lb[0] + (1 - lb[0]) * jax.nn.sigmoid(ff)
    f_b = lb[1] + (1 - lb[1]) * jax.nn.sigmoid(fb)
    return q, i, g, (jnp.log(f_f), 1 - f_f), (jnp.log(f_b), 1 - f_b)


def gla_chunked(q, k, v, logf, S0):
    B, L, H, DK = q.shape
    DV = v.shape[-1]
    nc = L // CHUNK

    def chunks(a):
        return a.reshape(B, nc, CHUNK, H, a.shape[-1]).transpose(1, 0, 3, 2, 4)

    mask = jnp.tril(jnp.ones((CHUNK, CHUNK), dtype=bool))[:, :, None]

    def step(S, inp):
        qc, kc, vc, gc = inp
        b = jnp.cumsum(gc, axis=2)
        o_inter = jnp.einsum('bhtk,bhkv->bhtv', qc * jnp.exp(b), S)
        diff = b[:, :, :, None, :] - b[:, :, None, :, :]
        dec = jnp.exp(jnp.where(mask, diff, -jnp.inf))
        A = jnp.einsum('bhtk,bhtsk,bhsk->bhts', qc, dec, kc)
        o_intra = jnp.einsum('bhts,bhsv->bhtv', A, vc)
        b_last = b[:, :, -1]
        S_new = jnp.exp(b_last)[..., None] * S + jnp.einsum(
            'bhsk,bhsv->bhkv', kc * jnp.exp(b_last[:, :, None] - b), vc)
        return S_new, o_inter + o_intra

    S_fin, o = lax.scan(step, S0, (chunks(q), chunks(k), chunks(v), chunks(logf)))
    return o.transpose(1, 0, 3, 2, 4).reshape(B, L, H, DV), S_fin


def hgrn_bidir(q, i, dir_f, dir_b, S0f, S0b):
    o_f, S_f = gla_chunked(q, dir_f[1], i, dir_f[0], S0f)
    fl = lambda a: a[:, ::-1]
    o_b, S_b = gla_chunked(fl(q), fl(dir_b[1]), fl(i), fl(dir_b[0]), S0b)
    return o_f + fl(o_b), S_f, S_b


def hgrn_out(o, g, gain, w_out, dtype):
    B, L = o.shape[:2]
    o = rmsnorm(o, gain) * jax.nn.sigmoid(g)
    return o.reshape(B, L, HG_HEADS * HG_DV).astype(dtype) @ w_out


def setup_inputs(seed: int = 0) -> dict:
    key = jax.random.key(seed)
    ks = jax.random.split(key, 24)
    f32 = jnp.float32

    def nrm(k, shape, scale):
        return jax.random.normal(k, shape, f32) * scale

    D = D_MODEL
    return {
        "x_prompt": nrm(ks[0], (BATCH, SEQ, D), 1.0),
        "x_sample": nrm(ks[1], (DEC_BATCH, DEC_SEQ, D), 1.0),
        "cache_k": nrm(ks[2], (DEC_BATCH, N_ATTN_LAYERS, PAST_LEN, DA_HEADS, 2, DA_DK), 1.0),
        "cache_v": nrm(ks[3], (DEC_BATCH, N_ATTN_LAYERS, PAST_LEN, DA_HEADS, DA_DV), 1.0),
        "state_hgrn": nrm(ks[4], (DEC_BATCH, N_HGRN_LAYERS, 2, HG_HEADS, HG_DK, HG_DV), 0.3),
        "c": nrm(ks[5], (DEC_BATCH, D), 1.0),
        "c_ctx": nrm(ks[6], (D,), 1.0),
        "w_mod": nrm(ks[7], (DEPTH, D, N_MOD * D), 0.5 * D ** -0.5),
        "b_mod": nrm(ks[8], (DEPTH, N_MOD * D), 0.02),
        "norm_g": 1.0 + nrm(ks[9], (DEPTH, 6, D), 0.02),
        "ffn_w_in": nrm(ks[10], (DEPTH, 2, D, 2 * FFN_HIDDEN), D ** -0.5),
        "ffn_w_out": nrm(ks[11], (DEPTH, 2, FFN_HIDDEN, D), FFN_HIDDEN ** -0.5),
        "attn_w_in": nrm(ks[12], (N_ATTN_LAYERS, D, 2 * DA_HEADS * 2 * DA_DK + DA_HEADS * DA_DV), D ** -0.5),
        "attn_w_out": nrm(ks[13], (N_ATTN_LAYERS, DA_HEADS * DA_DV, D), (DA_HEADS * DA_DV) ** -0.5),
        "attn_lambda": nrm(ks[14], (N_ATTN_LAYERS, 4, DA_DK), 0.1),
        "attn_subln": 1.0 + nrm(ks[15], (N_ATTN_LAYERS, DA_DV), 0.02),
        "hgrn_w_in": nrm(ks[16], (N_HGRN_LAYERS, D, 5 * HG_HEADS * HG_DK), D ** -0.5),
        "hgrn_w_out": nrm(ks[17], (N_HGRN_LAYERS, HG_HEADS * HG_DV, D), (HG_HEADS * HG_DV) ** -0.5),
        "hgrn_lower_bounds": nrm(ks[18], (DEPTH, 2, HG_HEADS * HG_DK), 0.5),
        "hgrn_gnorm": 1.0 + nrm(ks[19], (N_HGRN_LAYERS, HG_DV), 0.02),
    }


def reference(x_prompt, x_sample, cache_k, cache_v, state_hgrn, c, c_ctx, w_mod, b_mod, norm_g,
              ffn_w_in, ffn_w_out, attn_w_in, attn_w_out, attn_lambda, attn_subln,
              hgrn_w_in, hgrn_w_out, hgrn_lower_bounds, hgrn_gnorm):
    lb_soft = jax.nn.softmax(hgrn_lower_bounds.astype(jnp.float32), axis=0)
    lb_all = jnp.cumsum(lb_soft, axis=0) - lb_soft[0]
    mod_ctx_all = jnp.einsum('d,lde->le', jax.nn.silu(c_ctx), w_mod) + b_mod
    mod_lat_all = jnp.einsum('bd,lde->lbe', jax.nn.silu(c), w_mod) + b_mod[:, None]

    x = x_prompt
    Bp = x.shape[0]
    ks_list, vs_list, st_list = [], [], []
    for l in range(DEPTH):
        mod = mod_ctx_all[l].reshape(1, N_MOD, D_MODEL)
        x = ffn_sublayer(x, mod, 0, norm_g[l, 0], norm_g[l, 1], ffn_w_in[l, 0], ffn_w_out[l, 0])
        h = ada_pre(x, mod, 1, norm_g[l, 2])
        if l % N_MIXERS == 0:
            a = l // N_MIXERS
            lam_init = 0.8 - 0.6 * math.exp(-0.3 * l)
            lam = diff_lambda(attn_lambda[a], lam_init)
            q, k, v = diff_qkv(h, attn_w_in[a])
            o = diff_attention(q, k, v, lam)
            y = diff_out(o, lam_init, attn_subln[a], attn_w_out[a], h.dtype)
            ks_list.append(k)
            vs_list.append(v)
        else:
            r = l // N_MIXERS
            lb = lb_all[l].reshape(2, HG_HEADS, HG_DK)
            q, i, g, df, db = hgrn_proj(h, hgrn_w_in[r], lb)
            zero = jnp.zeros((Bp, HG_HEADS, HG_DK, HG_DV), jnp.float32)
            o, S_f, S_b = hgrn_bidir(q, i, df, db, zero, zero)
            y = hgrn_out(o, g, hgrn_gnorm[r], hgrn_w_out[r], h.dtype)
            st_list.append(jnp.stack([S_f, S_b], axis=1).astype(x.dtype))
        x = ada_post(x, y, mod, 1, norm_g[l, 3], 1.0)
        x = ffn_sublayer(x, mod, 2, norm_g[l, 4], norm_g[l, 5], ffn_w_in[l, 1], ffn_w_out[l, 1])
    y_prompt = x
    new_cache_k = jnp.stack(ks_list, axis=1)
    new_cache_v = jnp.stack(vs_list, axis=1)
    new_state_hgrn = jnp.stack(st_list, axis=1)

    x = x_sample
    Bs = x.shape[0]
    for l in range(DEPTH):
        mod = mod_lat_all[l].reshape(Bs, N_MOD, D_MODEL)
        x = ffn_sublayer(x, mod, 0, norm_g[l, 0], norm_g[l, 1], ffn_w_in[l, 0], ffn_w_out[l, 0])
        h = ada_pre(x, mod, 1, norm_g[l, 2])
        if l % N_MIXERS == 0:
            a = l // N_MIXERS
            lam_init = 0.8 - 0.6 * math.exp(-0.3 * l)
            lam = diff_lambda(attn_lambda[a], lam_init)
            q, k, v = diff_qkv(h, attn_w_in[a])
            q = axial_rope(q)
            k = axial_rope(k)
            k_all = jnp.concatenate([k, cache_k[:, a].astype(k.dtype)], axis=1)
            v_all = jnp.concatenate([v, cache_v[:, a].astype(v.dtype)], axis=1)
            o = diff_attention(q, k_all, v_all, lam)
            y = diff_out(o, lam_init, attn_subln[a], attn_w_out[a], h.dtype)
        else:
            r = l // N_MIXERS
            lb = lb_all[l].reshape(2, HG_HEADS, HG_DK)
            q, i, g, df, db = hgrn_proj(h, hgrn_w_in[r], lb)
            S0 = state_hgrn[:, r].astype(jnp.float32)
            o, _, _ = hgrn_bidir(q, i, df, db, S0[:, 0], S0[:, 1])
            y = hgrn_out(o, g, hgrn_gnorm[r], hgrn_w_out[r], h.dtype)
        x = ada_post(x, y, mod, 1, norm_g[l, 3], 1.0)
        x = ffn_sublayer(x, mod, 2, norm_g[l, 4], norm_g[l, 5], ffn_w_in[l, 1], ffn_w_out[l, 1])
    y_sample = x

    return (y_prompt, y_sample, new_cache_k, new_cache_v, new_state_hgrn)
```

```cpp
#include <hip/hip_runtime.h>
#include <hip/hip_cooperative_groups.h>
#include <cstdio>
#include <cstdint>
namespace cg = cooperative_groups;
namespace pg8 {
#define PG8_LAS __attribute__((address_space(3)))
typedef unsigned short bf16_t;
typedef short bf16x8 __attribute__((ext_vector_type(8)));
typedef float f32x4 __attribute__((ext_vector_type(4)));
typedef unsigned u32x4 __attribute__((ext_vector_type(4)));
constexpr int BM = 256, BK = 64, HALF = 128, HTB = HALF * BK * 2  , STAGE_BYTES = 8 * HTB, NXCD = 8, WGM = 8;

__host__ __device__ __forceinline__ int lds_byte(int r, int c) { const int st = (r >> 4) * 2 + (c >> 5), rr = r & 15, cc = c & 31, ob = rr * 64 + cc * 2; return st * 1024 + (ob ^ (((ob >> 9) & 1) << 5)); }
__host__ __device__ __forceinline__ void stage_rc(int b, int& R, int& C) { const int st = b / 1024, sb = b % 1024, swz = sb ^ (((sb >> 9) & 1) << 5); R = (st >> 1) * 16 + swz / 64; C = (st & 1) * 32 + (swz % 64) / 2; }
__host__ __device__ __forceinline__ int perm32(int rho) { const int n = rho >> 4, i = rho & 15; return 8 * (i >> 2) + 4 * n + (i & 3); }

struct Unit { int pm, pn; };
struct Gemm { const bf16_t* A; const bf16_t* Bt; int M, N, K; };

struct StaticOrder {
    int nM, nN, nwg, G, c;
    __host__ __device__ void init(int M, int N, int G_, int c_) { nM = M / BM; nN = N / BM; nwg = nM * nN; G = G_; c = c_; }
    __host__ __device__ bool next(int i, Unit& u) const {
        const long L = (long)i * G + c; if (L >= nwg) return false;
        int wgid = (int)L; { const int q = nwg / NXCD, r = nwg % NXCD, xcd = wgid % NXCD, off = wgid / NXCD; wgid = (xcd < r ? xcd * (q + 1) : r * (q + 1) + (xcd - r) * q) + off; }
        const int nig = WGM * nN, gid = wgid / nig, fm = gid * WGM, gsz = (nM - fm) < WGM ? (nM - fm) : WGM;
        u.pm = fm + ((wgid % nig) % gsz); u.pn = (wgid % nig) / gsz; return true;
    }
    __device__ __forceinline__ void a_ready(const Unit&) const {}
    __device__ __forceinline__ void done(const Unit&) const {}
};
template <class Epi, class Sched, bool ALIGN_EPI = false, bool SP2 = false>
__device__ __forceinline__ void gemm_phase(PG8_LAS unsigned char* lds, const Gemm g, const Sched& S, const Epi& E) {
    int tid_ = threadIdx.x; asm volatile("" : "+v"(tid_));
    const int tid = tid_, wid = __builtin_amdgcn_readfirstlane(tid >> 6), lane = tid & 63, wr = wid >> 2, wc = wid & 3, fr = lane & 15, fq = lane >> 4;
    const int K = g.K, nt = K / BK;
    unsigned voffA[2], voffB[2];
#pragma unroll
    for (int i = 0; i < 2; ++i) { int R, C; stage_rc(tid * 16 + i * 8192, R, C); const int Rb = Epi::PERM ? ((R & ~31) + perm32(R & 31)) : R;
        voffA[i] = (unsigned)(R * K + C) * 2u; voffB[i] = (unsigned)(Rb * K + C) * 2u; }
    const size_t kstep = (size_t)(BK * 2);
    const size_t hstep = (size_t)HALF * K * 2;
    const size_t tstep = 2 * hstep;
    const unsigned ldsw = (unsigned)wid * 1024u;
    const int aoff = lds_byte(wr * 64 + fr, fq * 8), boff = lds_byte(wc * 32 + fr, fq * 8);
#define PG8_SA(b, h) (((b) * 2 + (h)) * HTB)
#define PG8_SB(b, h) ((4 + (b) * 2 + (h)) * HTB)
#define PG8_STAGE(bufoff, gbase, voff) do { _Pragma("unroll") for (int _i = 0; _i < 2; ++_i) \
        __builtin_amdgcn_global_load_lds((const unsigned*)((const char*)(gbase) + (voff)[_i]), (PG8_LAS unsigned*)(lds + (bufoff) + ldsw + _i * 8192), 16, 0, 0); } while (0)
#define PG8_LDA(dst, b, h) do { _Pragma("unroll") for (int m = 0; m < 4; ++m) _Pragma("unroll") for (int k = 0; k < 2; ++k) dst[m][k] = *(const PG8_LAS bf16x8*)(lds + PG8_SA(b, h) + aoff + m * 2048 + k * 1024); } while (0)
#define PG8_LDB(dst, b, h) do { _Pragma("unroll") for (int n = 0; n < 2; ++n) _Pragma("unroll") for (int k = 0; k < 2; ++k) dst[n][k] = *(const PG8_LAS bf16x8*)(lds + PG8_SB(b, h) + boff + n * 2048 + k * 1024); } while (0)
#define PG8_MMA(ai, bj, At, Bt) do { __builtin_amdgcn_s_setprio(1); _Pragma("unroll") for (int m = 0; m < 4; ++m) _Pragma("unroll") for (int n = 0; n < 2; ++n) _Pragma("unroll") for (int k = 0; k < 2; ++k) \
        acc[ai][bj][m][n] = __builtin_amdgcn_mfma_f32_16x16x32_bf16(Bt[n][k], At[m][k], acc[ai][bj][m][n], 0, 0, 0); __builtin_amdgcn_s_setprio(0); } while (0)
#define PG8_WAIT_V(n) asm volatile("s_waitcnt vmcnt(" #n ")" ::: "memory")
#define PG8_WAIT_L(n) asm volatile("s_waitcnt lgkmcnt(" #n ")" ::: "memory")
#define PG8_BAR __builtin_amdgcn_s_barrier()
#define PG8_SCHED __builtin_amdgcn_sched_barrier(0)
    Unit cur, nxt; int ui = 0;
    if (!S.next(0, cur)) return;
    f32x4 acc[2][2][4][2];
#pragma unroll
    for (int a = 0; a < 2; ++a)
#pragma unroll
        for (int b = 0; b < 2; ++b)
#pragma unroll
            for (int m = 0; m < 4; ++m)
#pragma unroll
                for (int n = 0; n < 2; ++n) acc[a][b][m][n] = (f32x4){0.f, 0.f, 0.f, 0.f};
    bf16x8 At[4][2], B0[2][2], B1[2][2];
    const char* cA = (const char*)g.A + (size_t)cur.pm * tstep; const char* cB = (const char*)g.Bt + (size_t)cur.pn * tstep;
    S.a_ready(cur);
    if constexpr (SP2) {
        PG8_STAGE(PG8_SB(0, 0), cB, voffB); PG8_STAGE(PG8_SB(0, 1), cB + hstep, voffB); PG8_STAGE(PG8_SA(0, 0), cA, voffA); PG8_STAGE(PG8_SA(0, 1), cA + hstep, voffA);
        if (wr == 1) PG8_BAR;
        PG8_WAIT_V(2); PG8_BAR;
        PG8_STAGE(PG8_SB(1, 0), cB + kstep, voffB); PG8_STAGE(PG8_SA(1, 0), cA + kstep, voffA); PG8_STAGE(PG8_SB(1, 1), cB + hstep + kstep, voffB);
        PG8_WAIT_V(6); PG8_BAR;
    } else {
        PG8_STAGE(PG8_SB(0, 0), cB, voffB); PG8_STAGE(PG8_SA(0, 0), cA, voffA); PG8_STAGE(PG8_SB(0, 1), cB + hstep, voffB); PG8_STAGE(PG8_SA(0, 1), cA + hstep, voffA);
        if (wr == 1) PG8_BAR;
        PG8_WAIT_V(4); PG8_BAR;
        PG8_STAGE(PG8_SB(1, 0), cB + kstep, voffB); PG8_STAGE(PG8_SA(1, 0), cA + kstep, voffA); PG8_STAGE(PG8_SB(1, 1), cB + hstep + kstep, voffB);
        PG8_WAIT_V(6); PG8_BAR;
    }
    for (;;) {
        const bool has_next = S.next(ui + 1, nxt);
        const char* nA = has_next ? (const char*)g.A + (size_t)nxt.pm * tstep : cA; const char* nB = has_next ? (const char*)g.Bt + (size_t)nxt.pn * tstep : cB;
        for (int t = 0; t < nt; t += 2) {
            const bool last = (t == nt - 2);
            const char* a1 = cA + (size_t)(t + 1) * kstep;
            const char* a2 = last ? nA : cA + (size_t)(t + 2) * kstep; const char* b2 = last ? nB : cB + (size_t)(t + 2) * kstep;
            const char* a3 = a2 + kstep; const char* b3 = b2 + kstep;
            if (last && has_next) S.a_ready(nxt);
            if constexpr (SP2) {
            PG8_LDB(B0, 0, 0); PG8_LDB(B1, 0, 1); PG8_SCHED; PG8_LDA(At, 0, 0); PG8_STAGE(PG8_SA(1, 1), a1 + hstep, voffA);
            PG8_WAIT_V(8); PG8_WAIT_L(0); PG8_BAR; PG8_MMA(0, 0, At, B0); PG8_MMA(0, 1, At, B1); PG8_BAR; PG8_SCHED;
            PG8_LDA(At, 0, 1); PG8_STAGE(PG8_SB(0, 0), b2, voffB); PG8_STAGE(PG8_SB(0, 1), b2 + hstep, voffB); PG8_STAGE(PG8_SA(0, 0), a2, voffA);
            PG8_WAIT_V(8); PG8_WAIT_L(0); PG8_BAR; PG8_MMA(1, 0, At, B0); PG8_MMA(1, 1, At, B1); PG8_BAR; PG8_SCHED;
            PG8_LDB(B0, 1, 0); PG8_LDB(B1, 1, 1); PG8_SCHED; PG8_LDA(At, 1, 0); PG8_STAGE(PG8_SA(0, 1), a2 + hstep, voffA);
            PG8_WAIT_V(8); PG8_WAIT_L(0); PG8_BAR; PG8_MMA(0, 0, At, B0); PG8_MMA(0, 1, At, B1); PG8_BAR; PG8_SCHED;
            PG8_LDA(At, 1, 1); PG8_STAGE(PG8_SB(1, 0), b3, voffB); PG8_STAGE(PG8_SB(1, 1), b3 + hstep, voffB); PG8_STAGE(PG8_SA(1, 0), a3, voffA);
            PG8_WAIT_V(8); PG8_WAIT_L(0); PG8_BAR; PG8_MMA(1, 0, At, B0); PG8_MMA(1, 1, At, B1); PG8_BAR; PG8_SCHED;
            } else {
            PG8_LDB(B0, 0, 0); PG8_SCHED; PG8_LDA(At, 0, 0); PG8_STAGE(PG8_SA(1, 1), a1 + hstep, voffA);
            PG8_WAIT_L(8); PG8_BAR; PG8_WAIT_L(0); PG8_MMA(0, 0, At, B0); PG8_BAR; PG8_SCHED;
            PG8_LDB(B1, 0, 1); PG8_STAGE(PG8_SB(0, 0), b2, voffB);
            PG8_BAR; PG8_WAIT_L(0); PG8_MMA(0, 1, At, B1); PG8_BAR;
            PG8_LDA(At, 0, 1); PG8_STAGE(PG8_SA(0, 0), a2, voffA);
            PG8_BAR; PG8_WAIT_L(0); PG8_MMA(1, 0, At, B0); PG8_BAR; PG8_SCHED;
            PG8_STAGE(PG8_SB(0, 1), b2 + hstep, voffB);
            PG8_WAIT_V(6); PG8_BAR; PG8_MMA(1, 1, At, B1); PG8_BAR;
            PG8_LDB(B0, 1, 0); PG8_SCHED; PG8_LDA(At, 1, 0); PG8_STAGE(PG8_SA(0, 1), a2 + hstep, voffA);
            PG8_WAIT_L(8); PG8_BAR; PG8_WAIT_L(0); PG8_MMA(0, 0, At, B0); PG8_BAR; PG8_SCHED;
            PG8_LDB(B1, 1, 1); PG8_STAGE(PG8_SB(1, 0), b3, voffB);
            PG8_BAR; PG8_WAIT_L(0); PG8_MMA(0, 1, At, B1); PG8_BAR;
            PG8_LDA(At, 1, 1); PG8_STAGE(PG8_SA(1, 0), a3, voffA);
            PG8_BAR; PG8_WAIT_L(0); PG8_MMA(1, 0, At, B0); PG8_BAR; PG8_SCHED;
            PG8_STAGE(PG8_SB(1, 1), b3 + hstep, voffB);
            PG8_WAIT_V(6); PG8_BAR; PG8_MMA(1, 1, At, B1); PG8_BAR;
            }
        }
        if constexpr (ALIGN_EPI) { if (wr == 0) PG8_BAR; }
        if constexpr (!Epi::AFTER_DRAIN) { E(acc, cur, wr, wc, fr, fq); S.done(cur); }
        if (!has_next) break;
#pragma unroll
        for (int a = 0; a < 2; ++a)
#pragma unroll
            for (int b = 0; b < 2; ++b)
#pragma unroll
                for (int m = 0; m < 4; ++m)
#pragma unroll
                    for (int n = 0; n < 2; ++n) acc[a][b][m][n] = (f32x4){0.f, 0.f, 0.f, 0.f};
        cur = nxt; cA = nA; cB = nB; ++ui;
        if constexpr (ALIGN_EPI) { if (wr == 1) PG8_BAR; }
    }
    PG8_WAIT_V(0);
    if constexpr (!ALIGN_EPI) { if (wr == 0) PG8_BAR; }
    PG8_BAR;
    if constexpr (Epi::AFTER_DRAIN) { E.fused(acc, cur, wr, wc, fr, fq, lds, wid, lane); S.done(cur); }
#undef PG8_SA
#undef PG8_SB
#undef PG8_STAGE
#undef PG8_LDA
#undef PG8_LDB
#undef PG8_MMA
#undef PG8_WAIT_V
#undef PG8_WAIT_L
#undef PG8_BAR
#undef PG8_SCHED
}
}
#ifndef DI
#define DI __device__ __forceinline__
#endif
#define LAS __attribute__((address_space(3)))
typedef unsigned short bf16;
typedef float f32x2 __attribute__((ext_vector_type(2)));
typedef float f32x4 __attribute__((ext_vector_type(4)));
typedef float f32x16 __attribute__((ext_vector_type(16)));
typedef short bf16x8 __attribute__((ext_vector_type(8)));
typedef short s16x4 __attribute__((ext_vector_type(4)));
typedef unsigned u32x2 __attribute__((ext_vector_type(2)));
typedef unsigned u32x4 __attribute__((ext_vector_type(4)));
typedef __bf16 bf16x2_t __attribute__((ext_vector_type(2)));
DI unsigned cvtpk(float lo, float hi) { f32x2 v = {lo, hi}; bf16x2_t b = __builtin_convertvector(v, bf16x2_t); return __builtin_bit_cast(unsigned, b); }
DI float bf2f(bf16 b) { return __uint_as_float(((unsigned)b) << 16); }
DI float wave_sum(float v) {
#pragma unroll
    for (int o = 1; o < 64; o <<= 1) v += __shfl_xor(v, o);
    return v;
}
DI float fexp(float x) { return __builtin_amdgcn_exp2f(x * 1.4426950408889634f); }
DI float fsigmoid(float x) { return __builtin_amdgcn_rcpf(1.0f + fexp(-x)); }
DI f32x16 mfma32(bf16x8 a, bf16x8 b, f32x16 c) { return __builtin_amdgcn_mfma_f32_32x32x16_bf16(a, b, c, 0, 0, 0); }
DI bf16x8 pack8(const f32x16& x, int s) {
    u32x4 p;
    p[0] = cvtpk(x[8 * s + 0], x[8 * s + 1]); p[1] = cvtpk(x[8 * s + 2], x[8 * s + 3]);
    p[2] = cvtpk(x[8 * s + 4], x[8 * s + 5]); p[3] = cvtpk(x[8 * s + 6], x[8 * s + 7]);
    return __builtin_bit_cast(bf16x8, p);
}
DI bf16x8 cat4(s16x4 lo, s16x4 hi) { return __builtin_shufflevector(lo, hi, 0, 1, 2, 3, 4, 5, 6, 7); }

constexpr int D = 1024, TP = 4096, TSM = 8192, T = TP + TSM, FH = 2816, NMODE = 9 * D;
constexpr float EPS = 1e-6f;
constexpr size_t HM = 512u * 1024u;
constexpr size_t WS_MOD = 1 * HM;
constexpr size_t WS_FIN00 = 4 * HM, WS_FIN01 = 26 * HM, WS_FOUT00 = 48 * HM, WS_FOUT01 = 59 * HM, WS_AIN = 70 * HM, WS_AOUT = 82 * HM;
constexpr size_t WS_FIN10 = 86 * HM, WS_FOUT10 = 108 * HM, WS_HIN = 119 * HM, WS_FIN11 = 139 * HM, WS_FOUT11 = 161 * HM, WS_HOUT = 172 * HM;
constexpr size_t WS_H = 176 * HM;
constexpr size_t WS_Y = 224 * HM;
constexpr size_t WS_BIG = 320 * HM;
constexpr size_t WS_ACT = WS_BIG;
constexpr size_t WS_Q = WS_BIG, WS_K = WS_BIG + 48 * HM, WS_V = WS_K + 52 * HM;
constexpr size_t WS_HQ = WS_BIG, WS_HI = WS_BIG + 48 * HM, WS_HG = WS_BIG + 96 * HM, WS_LF = WS_BIG + 144 * HM;
constexpr size_t WS_LB = 4 * HM;
struct EpiF32 {
    static constexpr bool PERM = false, AFTER_DRAIN = false;
    float* C;
    DI void operator()(const f32x4 (&acc)[2][2][4][2], const pg8::Unit& u, int wr, int wc, int fr, int fq) const {
        const int row0 = u.pm * 256 + wr * 64 + fr, col0 = u.pn * 256 + wc * 32 + 4 * fq;
#pragma unroll
        for (int ai = 0; ai < 2; ++ai)
#pragma unroll
            for (int m = 0; m < 4; ++m) { float* rowp = C + (size_t)(row0 + ai * 128 + m * 16) * D + col0;
#pragma unroll
                for (int bj = 0; bj < 2; ++bj)
#pragma unroll
                    for (int n = 0; n < 2; ++n) *(f32x4*)(rowp + bj * 128 + n * 16) = acc[ai][bj][m][n]; }
    }
};
struct EpiSwiglu {
    static constexpr bool PERM = false, AFTER_DRAIN = false;
    bf16* O;
    DI void operator()(const f32x4 (&acc)[2][2][4][2], const pg8::Unit& u, int wr, int wc, int fr, int fq) const {
        const int row0 = u.pm * 256 + wr * 64 + fr, col0 = u.pn * 128 + wc * 32 + 4 * fq;
#pragma unroll
        for (int ai = 0; ai < 2; ++ai)
#pragma unroll
            for (int m = 0; m < 4; ++m) { bf16* rowp = O + (size_t)(row0 + ai * 128 + m * 16) * FH + col0;
#pragma unroll
                for (int n = 0; n < 2; ++n) { const f32x4 a = acc[ai][0][m][n], b = acc[ai][1][m][n]; float r[4];
#pragma unroll
                    for (int j = 0; j < 4; ++j) r[j] = a[j] * fsigmoid(a[j]) * b[j];
                    u32x2 w; w.x = cvtpk(r[0], r[1]); w.y = cvtpk(r[2], r[3]); *(u32x2*)(rowp + n * 16) = w; } }
    }
};
constexpr float QSCALE = 0.125f * 1.4426950408889634f;
struct EpiQKV {
    static constexpr bool PERM = false, AFTER_DRAIN = false;
    bf16 *Qb, *Kb, *Vb; float *nck, *ncv;
    DI void operator()(const f32x4 (&acc)[2][2][4][2], const pg8::Unit& u, int wr, int wc, int fr, int fq) const {
        const int sec = u.pn >> 2; const bool sample = u.pm >= 16;
        const int row0 = u.pm * 256 + wr * 64 + fr, col0 = (u.pn & 3) * 256 + wc * 32 + 4 * fq;
        if (sec == 2) {
#pragma unroll
            for (int ai = 0; ai < 2; ++ai)
#pragma unroll
                for (int m = 0; m < 4; ++m) { const size_t off = (size_t)(row0 + ai * 128 + m * 16) * D + col0;
#pragma unroll
                    for (int bj = 0; bj < 2; ++bj)
#pragma unroll
                        for (int n = 0; n < 2; ++n) { const f32x4 v = acc[ai][bj][m][n]; u32x2 w; w.x = cvtpk(v[0], v[1]); w.y = cvtpk(v[2], v[3]);
                            *(u32x2*)(Vb + off + bj * 128 + n * 16) = w; if (!sample) *(f32x4*)(ncv + off + bj * 128 + n * 16) = v; } }
        } else {
            float inv[4];
#pragma unroll
            for (int j = 0; j < 4; ++j) inv[j] = __builtin_amdgcn_exp2f(-(float)(4 * fq + j) * (13.287712379549449f / 16.0f)) * 0.15915494309189535f;
            const int axis = wc & 1;
            bf16* dst = sec == 0 ? Qb : Kb; const float sc = sec == 0 ? QSCALE : 1.0f;
#pragma unroll
            for (int ai = 0; ai < 2; ++ai)
#pragma unroll
                for (int m = 0; m < 4; ++m) { const int row = row0 + ai * 128 + m * 16; const size_t off = (size_t)row * D + col0;
                    const int t = (row - TP) & 2047; const float pos = (float)(axis ? (t & 63) : (t >> 6));
                    float cs[4], sn[4];
#pragma unroll
                    for (int j = 0; j < 4; ++j) { const float rev = __builtin_amdgcn_fractf(pos * inv[j]); cs[j] = sample ? __builtin_amdgcn_cosf(rev) : 1.0f; sn[j] = sample ? __builtin_amdgcn_sinf(rev) : 0.0f; }
#pragma unroll
                    for (int bj = 0; bj < 2; ++bj) { const f32x4 x1 = acc[ai][bj][m][0], x2 = acc[ai][bj][m][1]; f32x4 o1, o2;
#pragma unroll
                        for (int j = 0; j < 4; ++j) { o1[j] = x1[j] * cs[j] - x2[j] * sn[j]; o2[j] = x1[j] * sn[j] + x2[j] * cs[j]; }
                        if (sec == 1 && !sample) { *(f32x4*)(nck + off + bj * 128) = o1; *(f32x4*)(nck + off + bj * 128 + 16) = o2; }
                        u32x2 w1, w2; w1.x = cvtpk(o1[0] * sc, o1[1] * sc); w1.y = cvtpk(o1[2] * sc, o1[3] * sc); w2.x = cvtpk(o2[0] * sc, o2[1] * sc); w2.y = cvtpk(o2[2] * sc, o2[3] * sc);
                        *(u32x2*)(dst + off + bj * 128) = w1; *(u32x2*)(dst + off + bj * 128 + 16) = w2; } }
        }
    }
};
struct EpiHgrn {
    static constexpr bool PERM = false, AFTER_DRAIN = false;
    bf16 *HQ, *HI, *HG; float *LF, *LB; const float* hlb;
    DI void operator()(const f32x4 (&acc)[2][2][4][2], const pg8::Unit& u, int wr, int wc, int fr, int fq) const {
        const int sec = u.pn >> 2;
        const int row0 = u.pm * 256 + wr * 64 + fr, col0 = (u.pn & 3) * 256 + wc * 32 + 4 * fq;
        if (sec == 1 || sec == 2) {
            const int dir = sec - 1; float* L = dir ? LB : LF;
#pragma unroll
            for (int bj = 0; bj < 2; ++bj)
#pragma unroll
                for (int n = 0; n < 2; ++n) { const int col = col0 + bj * 128 + n * 16;
                    const f32x4 p0 = *(const f32x4*)(hlb + dir * 1024 + col), p1 = *(const f32x4*)(hlb + 2048 + dir * 1024 + col); float lb[4];
#pragma unroll
                    for (int j = 0; j < 4; ++j) lb[j] = __builtin_amdgcn_rcpf(1.0f + fexp(p0[j] - p1[j]));
#pragma unroll
                    for (int ai = 0; ai < 2; ++ai)
#pragma unroll
                        for (int m = 0; m < 4; ++m) { const f32x4 z = acc[ai][bj][m][n]; f32x4 o;
#pragma unroll
                            for (int j = 0; j < 4; ++j) { const float f = lb[j] + (1.0f - lb[j]) * fsigmoid(z[j]); o[j] = __builtin_amdgcn_logf(f) * 0.6931471805599453f; }
                            *(f32x4*)(L + (size_t)(row0 + ai * 128 + m * 16) * D + col) = o; } }
        } else {
            bf16* dst = HQ + (size_t)(sec == 0 ? 0 : sec - 2) * ((size_t)T * D);
#pragma unroll
            for (int ai = 0; ai < 2; ++ai)
#pragma unroll
                for (int m = 0; m < 4; ++m) { const size_t off = (size_t)(row0 + ai * 128 + m * 16) * D + col0;
#pragma unroll
                    for (int bj = 0; bj < 2; ++bj)
#pragma unroll
                        for (int n = 0; n < 2; ++n) { const f32x4 v = acc[ai][bj][m][n]; u32x2 w; w.x = cvtpk(v[0], v[1]); w.y = cvtpk(v[2], v[3]); *(u32x2*)(dst + off + bj * 128 + n * 16) = w; } }
        }
    }
};
DI void transpose_item(const float* W, int K, int N, bf16* WT, bool swig, LAS float* scr, int item, int lane) {
    const int nblk = N / 32, kb = item / nblk, nb = item % nblk, k0 = 64 * kb, n0 = 32 * nb;
    int r0 = n0;
    if (swig) { const int bj = n0 >= FH ? 1 : 0, uu = n0 - bj * FH; r0 = 256 * (uu >> 7) + 128 * bj + (uu & 127); }
#pragma unroll 8
    for (int i = 0; i < 32; ++i) { const int kk = 2 * i + (lane >> 5); scr[kk * 33 + (lane & 31)] = W[(size_t)(k0 + kk) * N + n0 + (lane & 31)]; }
    asm volatile("s_waitcnt lgkmcnt(0)" ::: "memory");
    const int c = lane & 7;
#pragma unroll
    for (int j = 0; j < 4; ++j) { const int n = (lane >> 3) + 8 * j; const LAS float* s = scr + (8 * c) * 33 + n;
        u32x4 o; o.x = cvtpk(s[0 * 33], s[1 * 33]); o.y = cvtpk(s[2 * 33], s[3 * 33]); o.z = cvtpk(s[4 * 33], s[5 * 33]); o.w = cvtpk(s[6 * 33], s[7 * 33]);
        *(u32x4*)(WT + (size_t)(r0 + n) * K + k0 + 8 * c) = o; }
    asm volatile("s_waitcnt lgkmcnt(0)" ::: "memory");
}

DI void norm_phase(const float* xp, const float* xs, const float* Y, float* X, bf16* H,
                   const float* modpost, int jpost, const float* gpost, float resw,
                   const float* modpre, int jpre, const float* gpre, int gw, int NGW, int lane) {
    for (int row = gw; row < T; row += NGW) {
        const int mi = row < TP ? 0 : 1 + ((row - TP) >> 11);
        const float* xr = row < TP ? xp + (size_t)row * D : xs + (size_t)(row - TP) * D;
        f32x4 v[4];
#pragma unroll
        for (int j = 0; j < 4; ++j) v[j] = *(const f32x4*)(xr + 4 * lane + 256 * j);
        if (Y) {
            f32x4 y[4]; float s = 0.f;
#pragma unroll
            for (int j = 0; j < 4; ++j) { y[j] = *(const f32x4*)(Y + (size_t)row * D + 4 * lane + 256 * j); s += (y[j].x * y[j].x + y[j].y * y[j].y) + (y[j].z * y[j].z + y[j].w * y[j].w); }
            const float rstd = __builtin_amdgcn_rsqf(wave_sum(s) * (1.0f / D) + EPS) * resw;
            const float* gate = modpost + (size_t)mi * NMODE + (3 * jpost + 2) * D;
#pragma unroll
            for (int j = 0; j < 4; ++j) { const f32x4 gt = *(const f32x4*)(gate + 4 * lane + 256 * j), gg = *(const f32x4*)(gpost + 4 * lane + 256 * j);
                v[j] = v[j] + gt * (y[j] * rstd) * gg; }
        }
#pragma unroll
        for (int j = 0; j < 4; ++j) *(f32x4*)(X + (size_t)row * D + 4 * lane + 256 * j) = v[j];
        if (H) {
            float s = 0.f;
#pragma unroll
            for (int j = 0; j < 4; ++j) s += (v[j].x * v[j].x + v[j].y * v[j].y) + (v[j].z * v[j].z + v[j].w * v[j].w);
            const float rstd = __builtin_amdgcn_rsqf(wave_sum(s) * (1.0f / D) + EPS);
            const float* sh = modpre + (size_t)mi * NMODE + (3 * jpre) * D; const float* sc = sh + D;
#pragma unroll
            for (int j = 0; j < 4; ++j) { const f32x4 a = *(const f32x4*)(sh + 4 * lane + 256 * j), b = *(const f32x4*)(sc + 4 * lane + 256 * j), gg = *(const f32x4*)(gpre + 4 * lane + 256 * j);
                const f32x4 h = (v[j] * rstd * gg) * (b + 1.0f) + a;
                u32x2 w; w.x = cvtpk(h.x, h.y); w.y = cvtpk(h.z, h.w); *(u32x2*)(H + (size_t)row * D + 4 * lane + 256 * j) = w; }
        }
    }
}

constexpr int AK_STRIDE = 272, AV_STRIDE = 136, AK_BYTES = 64 * AK_STRIDE, AV_BYTES = 128 * AV_STRIDE;
DI void attn_phase(LAS unsigned char* lds, const bf16* Qb, const bf16* Kb, const bf16* Vb, bf16* OB, const float* lamp, const float* subln) {
    int tid_ = threadIdx.x; asm volatile("" : "+v"(tid_));
    const int tid = tid_, lane = tid & 63, w = __builtin_amdgcn_readfirstlane(tid >> 6), r = lane & 31, h = lane >> 5;
    const int qg = w >> 1, c = w & 1;
    float lam;
    { const float a = lamp[lane] * lamp[64 + lane], b = lamp[128 + lane] * lamp[192 + lane];
      lam = fexp(wave_sum(a)) - fexp(wave_sum(b)) + 0.2f; }
    const float OUTSC = 0.8f;
    for (int u = blockIdx.x; u < 768; u += gridDim.x) {
        int qrow0, krow0, krow1, nt, nt0, head;
        if (u < 512) { const int b = u >> 7; head = (u >> 4) & 7; const int qb = u & 15; qrow0 = TP + b * 2048 + qb * 128; krow0 = TP + b * 2048; krow1 = T + b * 256; nt0 = 32; nt = 36; }
        else { const int pu = u - 512, b = pu >> 4; head = (pu >> 1) & 7; qrow0 = b * 256 + (pu & 1) * 128; krow0 = b * 256; krow1 = 0; nt0 = 4; nt = 4; }
        const int qrow = qrow0 + 32 * qg + r;
        bf16x8 qf[4];
#pragma unroll
        for (int kk = 0; kk < 4; ++kk) qf[kk] = *(const bf16x8*)(Qb + (size_t)qrow * D + head * 128 + c * 64 + 16 * kk + 8 * h);
        f32x16 O[4];
#pragma unroll
        for (int vt = 0; vt < 4; ++vt)
#pragma unroll
            for (int i = 0; i < 16; ++i) O[vt][i] = 0.f;
        float mrun = -1e30f, lrun = 0.f;
        const int kkey = tid >> 3, kch = tid & 7, vkey = tid & 63, vch = tid >> 6;
        u32x4 kr0, kr1, vr0, vr1;
#define ATT_LOAD(tt) do { const int _t = (tt); const size_t _rowk = (size_t)(_t < nt0 ? krow0 + 64 * _t : krow1 + 64 * (_t - nt0)); \
            const bf16* _kp = Kb + (_rowk + kkey) * D + head * 128 + kch * 16; kr0 = *(const u32x4*)_kp; kr1 = *(const u32x4*)(_kp + 8); \
            const bf16* _vp = Vb + (_rowk + vkey) * D + head * 128 + vch * 16; vr0 = *(const u32x4*)_vp; vr1 = *(const u32x4*)(_vp + 8); } while (0)
#define ATT_STORE(bufi) do { LAS unsigned char* _kb = lds + (bufi) * (AK_BYTES + AV_BYTES); LAS unsigned char* _vb = _kb + AK_BYTES; \
            *(LAS u32x4*)(_kb + kkey * AK_STRIDE + kch * 32) = kr0; *(LAS u32x4*)(_kb + kkey * AK_STRIDE + kch * 32 + 16) = kr1; \
            _Pragma("unroll") for (int _e = 0; _e < 4; ++_e) { \
                *(LAS unsigned short*)(_vb + (vch * 16 + 2 * _e) * AV_STRIDE + vkey * 2) = (unsigned short)(vr0[_e] & 0xffffu); \
                *(LAS unsigned short*)(_vb + (vch * 16 + 2 * _e + 1) * AV_STRIDE + vkey * 2) = (unsigned short)(vr0[_e] >> 16); \
                *(LAS unsigned short*)(_vb + (vch * 16 + 8 + 2 * _e) * AV_STRIDE + vkey * 2) = (unsigned short)(vr1[_e] & 0xffffu); \
                *(LAS unsigned short*)(_vb + (vch * 16 + 8 + 2 * _e + 1) * AV_STRIDE + vkey * 2) = (unsigned short)(vr1[_e] >> 16); } } while (0)
        ATT_LOAD(0); ATT_STORE(0);
        __syncthreads();
        for (int t = 0; t < nt; ++t) {
            if (t + 1 < nt) ATT_LOAD(t + 1);
            const LAS unsigned char* kb = lds + (t & 1) * (AK_BYTES + AV_BYTES); const LAS unsigned char* vb = kb + AK_BYTES;
#pragma unroll
            for (int sub = 0; sub < 2; ++sub) {
                f32x16 s;
#pragma unroll
                for (int i = 0; i < 16; ++i) s[i] = 0.f;
#pragma unroll
                for (int kk = 0; kk < 4; ++kk) { const bf16x8 ka = *(const LAS bf16x8*)(kb + (32 * sub + r) * AK_STRIDE + c * 128 + kk * 32 + h * 16);
                    s = mfma32(ka, qf[kk], s); }
                float mx = s[0];
#pragma unroll
                for (int i = 1; i < 16; ++i) mx = fmaxf(mx, s[i]);
                mx = fmaxf(mx, __shfl_xor(mx, 32));
                const float mnew = fmaxf(mrun, mx), alpha = __builtin_amdgcn_exp2f(mrun - mnew);
                mrun = mnew;
                float ps = 0.f;
#pragma unroll
                for (int i = 0; i < 16; ++i) { s[i] = __builtin_amdgcn_exp2f(s[i] - mnew); ps += s[i]; }
                lrun = lrun * alpha + ps;
                if (__any(alpha != 1.0f)) {
#pragma unroll
                    for (int vt = 0; vt < 4; ++vt)
#pragma unroll
                        for (int i = 0; i < 16; ++i) O[vt][i] *= alpha;
                }
                const bf16x8 pf0 = pack8(s, 0), pf1 = pack8(s, 1);
#pragma unroll
                for (int vt = 0; vt < 4; ++vt) {
                    const LAS unsigned char* vp = vb + (32 * vt + r) * AV_STRIDE + (32 * sub + 4 * h) * 2;
                    O[vt] = mfma32(cat4(*(const LAS s16x4*)vp, *(const LAS s16x4*)(vp + 16)), pf0, O[vt]);
                    O[vt] = mfma32(cat4(*(const LAS s16x4*)(vp + 32), *(const LAS s16x4*)(vp + 48)), pf1, O[vt]);
                }
            }
            if (t + 1 < nt) ATT_STORE((t + 1) & 1);
            __syncthreads();
        }
#undef ATT_LOAD
#undef ATT_STORE
        LAS float* ex = (LAS float*)lds;
        { const float lt = lrun + __shfl_xor(lrun, 32); const float il = __builtin_amdgcn_rcpf(lt);
#pragma unroll
          for (int vt = 0; vt < 4; ++vt)
#pragma unroll
              for (int i = 0; i < 16; ++i) O[vt][i] *= il; }
        if (c == 1) {
#pragma unroll
            for (int vt = 0; vt < 4; ++vt)
#pragma unroll
                for (int i = 0; i < 16; ++i) { const int v = 32 * vt + (i & 3) + 8 * (i >> 2) + 4 * h; ex[(qg * 128 + v) * 32 + r] = O[vt][i]; }
        }
        __syncthreads();
        if (c == 0) {
            float ssq = 0.f;
#pragma unroll
            for (int vt = 0; vt < 4; ++vt)
#pragma unroll
                for (int i = 0; i < 16; ++i) { const int v = 32 * vt + (i & 3) + 8 * (i >> 2) + 4 * h; const float o = O[vt][i] - lam * ex[(qg * 128 + v) * 32 + r]; O[vt][i] = o; ssq += o * o; }
            ssq += __shfl_xor(ssq, 32);
            const float rstd = __builtin_amdgcn_rsqf(ssq * (1.0f / 128.0f) + EPS) * OUTSC;
            bf16* orow = OB + (size_t)qrow * D + head * 128;
#pragma unroll
            for (int vt = 0; vt < 4; ++vt)
#pragma unroll
                for (int g4 = 0; g4 < 4; ++g4) { const int v = 32 * vt + 8 * g4 + 4 * h; const f32x4 gn = *(const f32x4*)(subln + v);
                    u32x2 wv; wv.x = cvtpk(O[vt][4 * g4] * rstd * gn.x, O[vt][4 * g4 + 1] * rstd * gn.y); wv.y = cvtpk(O[vt][4 * g4 + 2] * rstd * gn.z, O[vt][4 * g4 + 3] * rstd * gn.w);
                    *(u32x2*)(orow + v) = wv; }
        }
        __syncthreads();
    }
}

constexpr int SQ_STRIDE = 272, ST_STRIDE = 80;
constexpr int SG_QH = 0, SG_KH = 32 * SQ_STRIDE, SG_KT = 2 * 32 * SQ_STRIDE, SG_VT = SG_KT + 128 * ST_STRIDE, SG_DL = SG_VT + 128 * ST_STRIDE, SG_SSQ = SG_DL + 512, SG_BYTES = SG_SSQ + 512;
DI void scan_phase(LAS unsigned char* lds, const bf16* HQ, const bf16* HI, const bf16* HG, const float* LF, const float* LB, float* OS, bf16* OB,
                   const float* st_in, float* st_out, const float* gnorm) {
    int tid_ = threadIdx.x; asm volatile("" : "+v"(tid_));
    const int tid = tid_, lane = tid & 63, w = __builtin_amdgcn_readfirstlane(tid >> 6), r = lane & 31, h = lane >> 5;
    const int g = w >> 2, ws = w & 3, tg = tid & 255, kc = tg >> 1, th = tg & 1;
    LAS unsigned char* gl = lds + g * SG_BYTES;
    const float* LG = g ? LB : LF;
    for (int item = blockIdx.x; item < 160; item += gridDim.x) {
        int row0, L, head, b; bool sample;
        if (item < 32) { b = item >> 3; head = item & 7; row0 = TP + b * 2048; L = 2048; sample = true; }
        else { const int pi = item - 32; b = pi >> 3; head = pi & 7; row0 = b * 256; L = 256; sample = false; }
        const int nc = L / 32;
        const size_t cbase = (size_t)row0 * D + head * 128;
        const float* LGb = LG + cbase; const bf16* HQb = HQ + cbase; const bf16* HIb = HI + cbase;
        f32x16 S[4];
        if (sample) { const float* sp = st_in + (size_t)((b * 2 + g) * 8 + head) * 16384 + 32 * ws + r;
#pragma unroll
            for (int Tt = 0; Tt < 4; ++Tt)
#pragma unroll
                for (int i = 0; i < 16; ++i) S[Tt][i] = sp[(32 * Tt + (i & 3) + 8 * (i >> 2) + 4 * h) * 128];
        } else {
#pragma unroll
            for (int Tt = 0; Tt < 4; ++Tt)
#pragma unroll
                for (int i = 0; i < 16; ++i) S[Tt][i] = 0.f;
        }
        float la[16]; unsigned qv2[8], iv2[8];
#define SC_TOK(cc, t) (g ? (L - 1 - (32 * (cc) + (t))) : (32 * (cc) + (t)))
#define SC_LOAD(cc) do { _Pragma("unroll") for (int _t = 0; _t < 16; ++_t) la[_t] = LGb[(unsigned)(SC_TOK(cc, 16 * th + _t) * D + kc)]; \
            _Pragma("unroll") for (int _t = 0; _t < 16; _t += 2) { const unsigned _o0 = (unsigned)(SC_TOK(cc, 16 * th + _t) * D + kc), _o1 = (unsigned)(SC_TOK(cc, 16 * th + _t + 1) * D + kc); \
                qv2[_t >> 1] = (unsigned)HQb[_o0] | ((unsigned)HQb[_o1] << 16); iv2[_t >> 1] = (unsigned)HIb[_o0] | ((unsigned)HIb[_o1] << 16); } } while (0)
        SC_LOAD(0);
        for (int s = 0; s < nc; ++s) {
            float suma = 0.f;
#pragma unroll
            for (int t = 0; t < 16; ++t) suma += la[t];
            const float sumo = __shfl_xor(suma, 1), blast = suma + sumo;
            float bb = th ? sumo : 0.f;
            unsigned ktp[8], vtp[8];
#pragma unroll
            for (int tt = 0; tt < 16; tt += 2) {
                float ktv[2];
#pragma unroll
                for (int e = 0; e < 2; ++e) {
                    const float lft = la[tt + e];
                    bb += lft;
                    const float kk = 1.0f - fexp(lft);
                    const float qh = __uint_as_float(e ? (qv2[tt >> 1] & 0xffff0000u) : (qv2[tt >> 1] << 16)) * fexp(fmaxf(bb, -80.0f)), kh = kk * fexp(fminf(-bb, 80.0f));
                    ktv[e] = kk * fexp(blast - bb);
                    const int t = 16 * th + tt + e;
                    *(LAS unsigned short*)(gl + SG_QH + t * SQ_STRIDE + kc * 2) = (unsigned short)(cvtpk(qh, 0.f) & 0xffffu);
                    *(LAS unsigned short*)(gl + SG_KH + t * SQ_STRIDE + kc * 2) = (unsigned short)(cvtpk(kh, 0.f) & 0xffffu);
                }
                ktp[tt >> 1] = cvtpk(ktv[0], ktv[1]);
                vtp[tt >> 1] = iv2[tt >> 1];
            }
            { u32x4 a, bq; a.x = ktp[0]; a.y = ktp[1]; a.z = ktp[2]; a.w = ktp[3]; bq.x = ktp[4]; bq.y = ktp[5]; bq.z = ktp[6]; bq.w = ktp[7];
              *(LAS u32x4*)(gl + SG_KT + kc * ST_STRIDE + th * 32) = a; *(LAS u32x4*)(gl + SG_KT + kc * ST_STRIDE + th * 32 + 16) = bq;
              a.x = vtp[0]; a.y = vtp[1]; a.z = vtp[2]; a.w = vtp[3]; bq.x = vtp[4]; bq.y = vtp[5]; bq.z = vtp[6]; bq.w = vtp[7];
              *(LAS u32x4*)(gl + SG_VT + kc * ST_STRIDE + th * 32) = a; *(LAS u32x4*)(gl + SG_VT + kc * ST_STRIDE + th * 32 + 16) = bq; }
            if (th == 0) *(LAS float*)(gl + SG_DL + kc * 4) = fexp(blast);
            __syncthreads();
            if (s + 1 < nc) SC_LOAD(s + 1);
            f32x16 at;
#pragma unroll
            for (int i = 0; i < 16; ++i) at[i] = 0.f;
#pragma unroll
            for (int kk = 0; kk < 8; ++kk) { const bf16x8 ka = *(const LAS bf16x8*)(gl + SG_KH + r * SQ_STRIDE + kk * 32 + h * 16), qb = *(const LAS bf16x8*)(gl + SG_QH + r * SQ_STRIDE + kk * 32 + h * 16);
                at = mfma32(ka, qb, at); }
#pragma unroll
            for (int i = 0; i < 16; ++i) { const int srow = (i & 3) + 8 * (i >> 2) + 4 * h; at[i] = srow > r ? 0.f : at[i]; }
            f32x16 o;
#pragma unroll
            for (int i = 0; i < 16; ++i) o[i] = 0.f;
#pragma unroll
            for (int jj = 0; jj < 2; ++jj) { const LAS unsigned char* vp = gl + SG_VT + (32 * ws + r) * ST_STRIDE + (16 * jj + 4 * h) * 2;
                o = mfma32(cat4(*(const LAS s16x4*)vp, *(const LAS s16x4*)(vp + 16)), pack8(at, jj), o); }
#pragma unroll
            for (int Tt = 0; Tt < 4; ++Tt)
#pragma unroll
                for (int jj = 0; jj < 2; ++jj) { const LAS unsigned char* qp = gl + SG_QH + r * SQ_STRIDE + (32 * Tt + 16 * jj + 4 * h) * 2;
                    o = mfma32(pack8(S[Tt], jj), cat4(*(const LAS s16x4*)qp, *(const LAS s16x4*)(qp + 16)), o); }
#pragma unroll
            for (int Tt = 0; Tt < 4; ++Tt) {
#pragma unroll
                for (int g4 = 0; g4 < 4; ++g4) { const f32x4 dl = *(const LAS f32x4*)(gl + SG_DL + (32 * Tt + 8 * g4 + 4 * h) * 4);
                    S[Tt][4 * g4] *= dl.x; S[Tt][4 * g4 + 1] *= dl.y; S[Tt][4 * g4 + 2] *= dl.z; S[Tt][4 * g4 + 3] *= dl.w; }
#pragma unroll
                for (int jj = 0; jj < 2; ++jj) { const bf16x8 ka = *(const LAS bf16x8*)(gl + SG_KT + (32 * Tt + r) * ST_STRIDE + (16 * jj + 8 * h) * 2), vbq = *(const LAS bf16x8*)(gl + SG_VT + (32 * ws + r) * ST_STRIDE + (16 * jj + 8 * h) * 2);
                    S[Tt] = mfma32(ka, vbq, S[Tt]); }
            }
            const size_t obase = cbase + (size_t)SC_TOK(s, r) * D + 32 * ws + 4 * h;
            const bool second = (2 * s >= nc);
            if (!second) {
#pragma unroll
                for (int g4 = 0; g4 < 4; ++g4) { f32x4 v; v.x = o[4 * g4]; v.y = o[4 * g4 + 1]; v.z = o[4 * g4 + 2]; v.w = o[4 * g4 + 3]; *(f32x4*)(OS + obase + 8 * g4) = v; }
            } else {
                float ssq = 0.f;
#pragma unroll
                for (int g4 = 0; g4 < 4; ++g4) { const f32x4 p = *(const f32x4*)(OS + obase + 8 * g4);
                    o[4 * g4] += p.x; o[4 * g4 + 1] += p.y; o[4 * g4 + 2] += p.z; o[4 * g4 + 3] += p.w;
                    ssq += (o[4 * g4] * o[4 * g4] + o[4 * g4 + 1] * o[4 * g4 + 1]) + (o[4 * g4 + 2] * o[4 * g4 + 2] + o[4 * g4 + 3] * o[4 * g4 + 3]); }
                ssq += __shfl_xor(ssq, 32);
                if (h == 0) *(LAS float*)(gl + SG_SSQ + (r * 4 + ws) * 4) = ssq;
                __syncthreads();
                const f32x4 sq = *(const LAS f32x4*)(gl + SG_SSQ + r * 16);
                const float rstd = __builtin_amdgcn_rsqf(((sq.x + sq.y) + (sq.z + sq.w)) * (1.0f / 128.0f) + EPS);
#pragma unroll
                for (int g4 = 0; g4 < 4; ++g4) { const u32x2 gg = *(const u32x2*)(HG + obase + 8 * g4); const f32x4 gn = *(const f32x4*)(gnorm + 32 * ws + 4 * h + 8 * g4);
                    const float g0 = __uint_as_float(gg.x << 16), g1 = __uint_as_float(gg.x & 0xffff0000u), g2 = __uint_as_float(gg.y << 16), g3 = __uint_as_float(gg.y & 0xffff0000u);
                    u32x2 wv; wv.x = cvtpk(o[4 * g4] * rstd * gn.x * fsigmoid(g0), o[4 * g4 + 1] * rstd * gn.y * fsigmoid(g1));
                    wv.y = cvtpk(o[4 * g4 + 2] * rstd * gn.z * fsigmoid(g2), o[4 * g4 + 3] * rstd * gn.w * fsigmoid(g3));
                    *(u32x2*)(OB + obase + 8 * g4) = wv; }
            }
            asm volatile("s_waitcnt vmcnt(0)" ::: "memory");
            __syncthreads();
        }
#undef SC_LOAD
        if (!sample) { float* sp = st_out + (size_t)((b * 2 + g) * 8 + head) * 16384 + 32 * ws + r;
#pragma unroll
            for (int Tt = 0; Tt < 4; ++Tt)
#pragma unroll
                for (int i = 0; i < 16; ++i) sp[(32 * Tt + (i & 3) + 8 * (i >> 2) + 4 * h) * 128] = S[Tt][i];
        }
    }
#undef SC_TOK
}

struct Args {
    const float *xp, *xs, *cache_k, *cache_v, *state, *c, *cctx, *wmod, *bmod, *normg, *ffn_in, *ffn_out, *attn_in, *attn_out, *attn_lam, *attn_subln, *hgrn_in, *hgrn_out, *hgrn_lb, *hgrn_gn;
    float* out; unsigned char* ws;
};
constexpr int LDS_BYTES = 147456;
constexpr size_t OUT_NCK = (size_t)T * D, OUT_NCV = OUT_NCK + (size_t)TP * D, OUT_ST = OUT_NCV + (size_t)TP * D;

typedef const __attribute__((address_space(4))) Args* KArgs;
#define KA() ({ KArgs _p = (KArgs)__builtin_amdgcn_kernarg_segment_ptr(); asm volatile("" : "+s"(_p)); _p; })
__global__ void __launch_bounds__(512) fwd_kernel(Args a_unused) {
    extern __shared__ __attribute__((aligned(16))) unsigned char lds_raw[];
    LAS unsigned char* lds = (LAS unsigned char*)lds_raw;
    cg::grid_group grid = cg::this_grid();
    const int G = gridDim.x;
#define TIDV() ({ int _t = threadIdx.x; asm volatile("" : "+v"(_t)); _t; })

    {
        KArgs a = KA(); unsigned char* ws = a->ws; float* MOD = (float*)(ws + WS_MOD);
        const int tid = TIDV(), lane = tid & 63, wave = __builtin_amdgcn_readfirstlane(tid >> 6), gw = blockIdx.x * 8 + wave, NGW = G * 8;
        LAS float* sv = (LAS float*)lds; LAS float* red = (LAS float*)(lds + 20480);
        for (int i = tid; i < 5 * D; i += 512) { const int mi = i >> 10, d = i & 1023; const float x = mi ? a->c[(mi - 1) * D + d] : a->cctx[d]; sv[i] = x * fsigmoid(x); }
        __syncthreads();
        for (int unit = blockIdx.x; unit < 288; unit += G) {
            const int l = unit / 144, cb = unit % 144, col = cb * 64 + lane;
            const float* wp = a->wmod + (size_t)l * D * NMODE + (size_t)(128 * wave) * NMODE + col;
            float a0 = 0.f, a1 = 0.f, a2 = 0.f, a3 = 0.f, a4 = 0.f;
#pragma unroll 8
            for (int d = 0; d < 128; ++d) { const float wv = wp[(size_t)d * NMODE]; const int dd = 128 * wave + d;
                a0 += sv[dd] * wv; a1 += sv[D + dd] * wv; a2 += sv[2 * D + dd] * wv; a3 += sv[3 * D + dd] * wv; a4 += sv[4 * D + dd] * wv; }
            red[(wave * 5 + 0) * 64 + lane] = a0; red[(wave * 5 + 1) * 64 + lane] = a1; red[(wave * 5 + 2) * 64 + lane] = a2; red[(wave * 5 + 3) * 64 + lane] = a3; red[(wave * 5 + 4) * 64 + lane] = a4;
            __syncthreads();
            if (tid < 320) { const int mi = tid >> 6, cl = tid & 63; float sacc = 0.f;
#pragma unroll
                for (int ww = 0; ww < 8; ++ww) sacc += red[(ww * 5 + mi) * 64 + cl];
                MOD[(size_t)(l * 5 + mi) * NMODE + cb * 64 + cl] = sacc + a->bmod[l * NMODE + cb * 64 + cl]; }
            __syncthreads();
        }
        LAS float* scr = (LAS float*)(lds + 32768 + wave * 8448);
        constexpr int I_FIN = 16 * 176, I_FOUT = 44 * 32, I_AIN = 16 * 96, I_SQ = 16 * 32, I_HIN = 16 * 160;
        constexpr int NITEMS = 4 * I_FIN + 4 * I_FOUT + I_AIN + I_SQ + I_HIN + I_SQ;
        for (int it = gw; it < NITEMS; it += NGW) {
            int q = it;
            if (q < 4 * I_FIN) { const int m = q / I_FIN; q -= m * I_FIN;
                bf16* dst = (bf16*)(ws + (m == 0 ? WS_FIN00 : m == 1 ? WS_FIN01 : m == 2 ? WS_FIN10 : WS_FIN11));
                transpose_item(a->ffn_in + (size_t)m * D * (2 * FH), D, 2 * FH, dst, true, scr, q, lane); continue; }
            q -= 4 * I_FIN;
            if (q < 4 * I_FOUT) { const int m = q / I_FOUT; q -= m * I_FOUT;
                bf16* dst = (bf16*)(ws + (m == 0 ? WS_FOUT00 : m == 1 ? WS_FOUT01 : m == 2 ? WS_FOUT10 : WS_FOUT11));
                transpose_item(a->ffn_out + (size_t)m * FH * D, FH, D, dst, false, scr, q, lane); continue; }
            q -= 4 * I_FOUT;
            if (q < I_AIN) { transpose_item(a->attn_in, D, 3 * D, (bf16*)(ws + WS_AIN), false, scr, q, lane); continue; }
            q -= I_AIN;
            if (q < I_SQ) { transpose_item(a->attn_out, D, D, (bf16*)(ws + WS_AOUT), false, scr, q, lane); continue; }
            q -= I_SQ;
            if (q < I_HIN) { transpose_item(a->hgrn_in, D, 5 * D, (bf16*)(ws + WS_HIN), false, scr, q, lane); continue; }
            q -= I_HIN;
            transpose_item(a->hgrn_out, D, D, (bf16*)(ws + WS_HOUT), false, scr, q, lane);
        }
    }
    grid.sync();
#define NORM(YY, HH, lpost, jpost, gpost_i, resw, lpre, jpre, gpre_i) do { KArgs a = KA(); unsigned char* ws = a->ws; float* MOD = (float*)(ws + WS_MOD); float* X = a->out; \
        const int tid = TIDV(), lane = tid & 63, wave = __builtin_amdgcn_readfirstlane(tid >> 6); \
        norm_phase(X, X + (size_t)TP * D, (YY) ? (const float*)(ws + WS_Y) : nullptr, X, (HH) ? (bf16*)(ws + WS_H) : nullptr, MOD + (size_t)(lpost) * 5 * NMODE, (jpost), a->normg + (size_t)(gpost_i) * D, (resw), \
                   MOD + (size_t)(lpre) * 5 * NMODE, (jpre), a->normg + (size_t)(gpre_i) * D, blockIdx.x * 8 + wave, G * 8, lane); } while (0)
    { KArgs a = KA(); unsigned char* ws = a->ws; float* MOD = (float*)(ws + WS_MOD);
      const int tid = TIDV(), lane = tid & 63, wave = __builtin_amdgcn_readfirstlane(tid >> 6);
      norm_phase(a->xp, a->xs, nullptr, a->out, (bf16*)(ws + WS_H), MOD, 0, a->normg, 0.f, MOD, 0, a->normg, blockIdx.x * 8 + wave, G * 8, lane); }
    grid.sync();
    for (int l = 0; l < 2; ++l) {
        for (int half = 0; half < 2; ++half) {
            {
                unsigned char* ws = KA()->ws;
                const bf16* Wt = (const bf16*)(ws + (l == 0 ? (half ? WS_FIN01 : WS_FIN00) : (half ? WS_FIN11 : WS_FIN10)));
                pg8::Gemm g{(const bf16*)(ws + WS_H), Wt, T, 2 * FH, D}; pg8::StaticOrder S; S.init(T, 2 * FH, G, (int)blockIdx.x);
                EpiSwiglu E{(bf16*)(ws + WS_ACT)};
                pg8::gemm_phase<EpiSwiglu, pg8::StaticOrder, true, true>(lds, g, S, E);
            }
            grid.sync();
            {
                unsigned char* ws = KA()->ws;
                const bf16* Wt = (const bf16*)(ws + (l == 0 ? (half ? WS_FOUT01 : WS_FOUT00) : (half ? WS_FOUT11 : WS_FOUT10)));
                pg8::Gemm g{(const bf16*)(ws + WS_ACT), Wt, T, D, FH}; pg8::StaticOrder S; S.init(T, D, G, (int)blockIdx.x);
                EpiF32 E{(float*)(ws + WS_Y)};
                pg8::gemm_phase<EpiF32, pg8::StaticOrder, true, true>(lds, g, S, E);
            }
            grid.sync();
            if (half == 0) NORM(true, true, l, 0, l * 6 + 1, 0.5f, l, 1, l * 6 + 2);
            else if (l == 0) NORM(true, true, 0, 2, 5, 0.5f, 1, 0, 6);
            else NORM(true, false, 1, 2, 11, 0.5f, 1, 0, 6);
            if (half == 1) { if (l == 0) grid.sync(); continue; }
            grid.sync();
            if (l == 0) {
                { KArgs a = KA(); unsigned char* ws = a->ws;
                  pg8::Gemm g{(const bf16*)(ws + WS_H), (const bf16*)(ws + WS_AIN), T, 3 * D, D}; pg8::StaticOrder S; S.init(T, 3 * D, G, (int)blockIdx.x);
                  EpiQKV E{(bf16*)(ws + WS_Q), (bf16*)(ws + WS_K), (bf16*)(ws + WS_V), a->out + OUT_NCK, a->out + OUT_NCV};
                  pg8::gemm_phase<EpiQKV, pg8::StaticOrder, true, true>(lds, g, S, E);
                  const int tid = TIDV();
                  bf16* Kc = (bf16*)(ws + WS_K) + (size_t)T * D; bf16* Vc = (bf16*)(ws + WS_V) + (size_t)T * D;
                  const float* ck = a->cache_k; const float* cv = a->cache_v;
                  for (int i = blockIdx.x * 512 + tid; i < 1024 * D / 4; i += G * 512) {
                      const f32x4 k4 = *(const f32x4*)(ck + 4 * (size_t)i), v4 = *(const f32x4*)(cv + 4 * (size_t)i);
                      u32x2 kw, vw; kw.x = cvtpk(k4.x, k4.y); kw.y = cvtpk(k4.z, k4.w); vw.x = cvtpk(v4.x, v4.y); vw.y = cvtpk(v4.z, v4.w);
                      *(u32x2*)(Kc + 4 * (size_t)i) = kw; *(u32x2*)(Vc + 4 * (size_t)i) = vw; }
                }
                grid.sync();
#ifndef NO_ATTN
                { KArgs a = KA(); unsigned char* ws = a->ws;
                  attn_phase(lds, (const bf16*)(ws + WS_Q), (const bf16*)(ws + WS_K), (const bf16*)(ws + WS_V), (bf16*)(ws + WS_H), a->attn_lam, a->attn_subln); }
#endif
                grid.sync();
                { unsigned char* ws = KA()->ws;
                  pg8::Gemm g{(const bf16*)(ws + WS_H), (const bf16*)(ws + WS_AOUT), T, D, D}; pg8::StaticOrder S; S.init(T, D, G, (int)blockIdx.x);
                  EpiF32 E{(float*)(ws + WS_Y)};
                  pg8::gemm_phase<EpiF32, pg8::StaticOrder, true, true>(lds, g, S, E); }
            } else {
                { KArgs a = KA(); unsigned char* ws = a->ws;
                  pg8::Gemm g{(const bf16*)(ws + WS_H), (const bf16*)(ws + WS_HIN), T, 5 * D, D}; pg8::StaticOrder S; S.init(T, 5 * D, G, (int)blockIdx.x);
                  EpiHgrn E{(bf16*)(ws + WS_HQ), (bf16*)(ws + WS_HI), (bf16*)(ws + WS_HG), (float*)(ws + WS_LF), (float*)(ws + WS_LB), a->hgrn_lb};
                  pg8::gemm_phase<EpiHgrn, pg8::StaticOrder, true, true>(lds, g, S, E); }
                grid.sync();
#ifndef NO_SCAN
                { KArgs a = KA(); unsigned char* ws = a->ws;
                  scan_phase(lds, (const bf16*)(ws + WS_HQ), (const bf16*)(ws + WS_HI), (const bf16*)(ws + WS_HG), (const float*)(ws + WS_LF), (const float*)(ws + WS_LB), (float*)(ws + WS_Y), (bf16*)(ws + WS_H),
                             a->state, a->out + OUT_ST, a->hgrn_gn); }
#endif
                grid.sync();
                { unsigned char* ws = KA()->ws;
                  pg8::Gemm g{(const bf16*)(ws + WS_H), (const bf16*)(ws + WS_HOUT), T, D, D}; pg8::StaticOrder S; S.init(T, D, G, (int)blockIdx.x);
                  EpiF32 E{(float*)(ws + WS_Y)};
                  pg8::gemm_phase<EpiF32, pg8::StaticOrder, true, true>(lds, g, S, E); }
            }
            grid.sync();
            NORM(true, true, l, 1, l * 6 + 3, 1.0f, l, 2, l * 6 + 4);
            grid.sync();
        }
    }
}

extern "C" void kernel_launch(void* const* d_in, const int* in_sizes, int n_in, void* d_out, int out_size, void* d_ws, size_t ws_size, hipStream_t stream) {
    static int grid = 0;
    if (!grid) {
        int dev = 0, cus = 0, per = 0;
        (void)hipGetDevice(&dev);
        (void)hipDeviceGetAttribute(&cus, hipDeviceAttributeMultiprocessorCount, dev);
        (void)hipFuncSetAttribute((const void*)fwd_kernel, hipFuncAttributeMaxDynamicSharedMemorySize, LDS_BYTES);
        (void)hipOccupancyMaxActiveBlocksPerMultiprocessor(&per, (const void*)fwd_kernel, 512, LDS_BYTES);
        if (per < 1) fprintf(stderr, "kernel_launch: occupancy query says %d blocks per CU\n", per);
        grid = cus > 0 ? cus : 256;
        if (ws_size < 280u * 1024u * 1024u) fprintf(stderr, "kernel_launch: workspace too small (%zu)\n", ws_size);
    }
    Args a{};
    a.xp = (const float*)d_in[0]; a.xs = (const float*)d_in[1]; a.cache_k = (const float*)d_in[2]; a.cache_v = (const float*)d_in[3]; a.state = (const float*)d_in[4];
    a.c = (const float*)d_in[5]; a.cctx = (const float*)d_in[6]; a.wmod = (const float*)d_in[7]; a.bmod = (const float*)d_in[8]; a.normg = (const float*)d_in[9];
    a.ffn_in = (const float*)d_in[10]; a.ffn_out = (const float*)d_in[11]; a.attn_in = (const float*)d_in[12]; a.attn_out = (const float*)d_in[13];
    a.attn_lam = (const float*)d_in[14]; a.attn_subln = (const float*)d_in[15]; a.hgrn_in = (const float*)d_in[16]; a.hgrn_out = (const float*)d_in[17];
    a.hgrn_lb = (const float*)d_in[18]; a.hgrn_gn = (const float*)d_in[19];
    a.out = (float*)d_out; a.ws = (unsigned char*)d_ws;
    void* args[] = {&a};
    hipError_t e = hipLaunchCooperativeKernel((void*)fwd_kernel, dim3(grid), dim3(512), args, LDS_BYTES, stream);
    if (e != hipSuccess) fprintf(stderr, "kernel_launch: cooperative launch failed: %s (grid %d)\n", hipGetErrorString(e), grid);
}
```

```cpp
#include <hip/hip_runtime.h>
#include <hip/hip_cooperative_groups.h>
#include <cstdio>
#include <cstdint>
namespace cg = cooperative_groups;
#ifndef REP_P0
#define REP_P0 1
#endif
#ifndef REP_ATTN
#define REP_ATTN 1
#endif
#ifndef REP_SCAN
#define REP_SCAN 1
#endif
#ifndef REP_SYNC
#define REP_SYNC 1
#endif
#define GSYNC() do { for (int _r = 0; _r < REP_SYNC; ++_r) xcd_barrier(xbar); } while (0)
namespace pg8 {
#define PG8_LAS __attribute__((address_space(3)))
typedef unsigned short bf16_t;
typedef short bf16x8 __attribute__((ext_vector_type(8)));
typedef float f32x4 __attribute__((ext_vector_type(4)));
typedef unsigned u32x4 __attribute__((ext_vector_type(4)));
constexpr int BM = 256, BK = 64, HALF = 128, HTB = HALF * BK * 2  , STAGE_BYTES = 8 * HTB, NXCD = 8, WGM = 8;

__host__ __device__ __forceinline__ int lds_byte(int r, int c) { const int st = (r >> 4) * 2 + (c >> 5), rr = r & 15, cc = c & 31, ob = rr * 64 + cc * 2; return st * 1024 + (ob ^ (((ob >> 9) & 1) << 5)); }
__host__ __device__ __forceinline__ void stage_rc(int b, int& R, int& C) { const int st = b / 1024, sb = b % 1024, swz = sb ^ (((sb >> 9) & 1) << 5); R = (st >> 1) * 16 + swz / 64; C = (st & 1) * 32 + (swz % 64) / 2; }
__host__ __device__ __forceinline__ int perm32(int rho) { const int n = rho >> 4, i = rho & 15; return 8 * (i >> 2) + 4 * n + (i & 3); }

struct Unit { int pm, pn; };
struct Gemm { const bf16_t* A; const bf16_t* Bt; int M, N, K; };

struct StaticOrder {
    int nM, nN, nwg, G, c;
    __host__ __device__ void init(int M, int N, int G_, int c_) { nM = M / BM; nN = N / BM; nwg = nM * nN; G = G_; c = c_; }
    __host__ __device__ bool next(int i, Unit& u) const {
        const long L = (long)i * G + c; if (L >= nwg) return false;
        int wgid = (int)L; { const int q = nwg / NXCD, r = nwg % NXCD, xcd = wgid % NXCD, off = wgid / NXCD; wgid = (xcd < r ? xcd * (q + 1) : r * (q + 1) + (xcd - r) * q) + off; }
        const int nig = WGM * nN, gid = wgid / nig, fm = gid * WGM, gsz = (nM - fm) < WGM ? (nM - fm) : WGM;
        u.pm = fm + ((wgid % nig) % gsz); u.pn = (wgid % nig) / gsz; return true;
    }
    __device__ __forceinline__ void a_ready(const Unit&) const {}
    __device__ __forceinline__ void done(const Unit&) const {}
};
template <class Epi, class Sched, bool ALIGN_EPI = false, bool SP2 = false>
__device__ __forceinline__ void gemm_phase(PG8_LAS unsigned char* lds, const Gemm g, const Sched& S, const Epi& E) {
    int tid_ = threadIdx.x; asm volatile("" : "+v"(tid_));
    const int tid = tid_, wid = __builtin_amdgcn_readfirstlane(tid >> 6), lane = tid & 63, wr = wid >> 2, wc = wid & 3, fr = lane & 15, fq = lane >> 4;
    const int K = g.K, nt = K / BK;
    unsigned voffA[2], voffB[2];
#pragma unroll
    for (int i = 0; i < 2; ++i) { int R, C; stage_rc(tid * 16 + i * 8192, R, C); const int Rb = Epi::PERM ? ((R & ~31) + perm32(R & 31)) : R;
        voffA[i] = (unsigned)(R * K + C) * 2u; voffB[i] = (unsigned)(Rb * K + C) * 2u; }
    const size_t kstep = (size_t)(BK * 2);
    const size_t hstep = (size_t)HALF * K * 2;
    const size_t tstep = 2 * hstep;
    const unsigned ldsw = (unsigned)wid * 1024u;
    const int aoff = lds_byte(wr * 64 + fr, fq * 8), boff = lds_byte(wc * 32 + fr, fq * 8);
#define PG8_SA(b, h) (((b) * 2 + (h)) * HTB)
#define PG8_SB(b, h) ((4 + (b) * 2 + (h)) * HTB)
#define PG8_STAGE(bufoff, gbase, voff) do { _Pragma("unroll") for (int _i = 0; _i < 2; ++_i) \
        __builtin_amdgcn_global_load_lds((const unsigned*)((const char*)(gbase) + (voff)[_i]), (PG8_LAS unsigned*)(lds + (bufoff) + ldsw + _i * 8192), 16, 0, 0); } while (0)
#define PG8_LDA(dst, b, h) do { _Pragma("unroll") for (int m = 0; m < 4; ++m) _Pragma("unroll") for (int k = 0; k < 2; ++k) dst[m][k] = *(const PG8_LAS bf16x8*)(lds + PG8_SA(b, h) + aoff + m * 2048 + k * 1024); } while (0)
#define PG8_LDB(dst, b, h) do { _Pragma("unroll") for (int n = 0; n < 2; ++n) _Pragma("unroll") for (int k = 0; k < 2; ++k) dst[n][k] = *(const PG8_LAS bf16x8*)(lds + PG8_SB(b, h) + boff + n * 2048 + k * 1024); } while (0)
#define PG8_MMA(ai, bj, At, Bt) do { __builtin_amdgcn_s_setprio(1); _Pragma("unroll") for (int m = 0; m < 4; ++m) _Pragma("unroll") for (int n = 0; n < 2; ++n) _Pragma("unroll") for (int k = 0; k < 2; ++k) \
        acc[ai][bj][m][n] = __builtin_amdgcn_mfma_f32_16x16x32_bf16(Bt[n][k], At[m][k], acc[ai][bj][m][n], 0, 0, 0); __builtin_amdgcn_s_setprio(0); } while (0)
#define PG8_WAIT_V(n) asm volatile("s_waitcnt vmcnt(" #n ")" ::: "memory")
#define PG8_WAIT_L(n) asm volatile("s_waitcnt lgkmcnt(" #n ")" ::: "memory")
#define PG8_BAR __builtin_amdgcn_s_barrier()
#define PG8_SCHED __builtin_amdgcn_sched_barrier(0)
    Unit cur, nxt; int ui = 0;
    if (!S.next(0, cur)) return;
    f32x4 acc[2][2][4][2];
#pragma unroll
    for (int a = 0; a < 2; ++a)
#pragma unroll
        for (int b = 0; b < 2; ++b)
#pragma unroll
            for (int m = 0; m < 4; ++m)
#pragma unroll
                for (int n = 0; n < 2; ++n) acc[a][b][m][n] = (f32x4){0.f, 0.f, 0.f, 0.f};
    bf16x8 At[4][2], B0[2][2], B1[2][2];
    const char* cA = (const char*)g.A + (size_t)cur.pm * tstep; const char* cB = (const char*)g.Bt + (size_t)cur.pn * tstep;
    S.a_ready(cur);
    if constexpr (SP2) {
        PG8_STAGE(PG8_SB(0, 0), cB, voffB); PG8_STAGE(PG8_SB(0, 1), cB + hstep, voffB); PG8_STAGE(PG8_SA(0, 0), cA, voffA); PG8_STAGE(PG8_SA(0, 1), cA + hstep, voffA);
        if (wr == 1) PG8_BAR;
        PG8_WAIT_V(2); PG8_BAR;
        PG8_STAGE(PG8_SB(1, 0), cB + kstep, voffB); PG8_STAGE(PG8_SA(1, 0), cA + kstep, voffA); PG8_STAGE(PG8_SB(1, 1), cB + hstep + kstep, voffB);
        PG8_WAIT_V(6); PG8_BAR;
    } else {
        PG8_STAGE(PG8_SB(0, 0), cB, voffB); PG8_STAGE(PG8_SA(0, 0), cA, voffA); PG8_STAGE(PG8_SB(0, 1), cB + hstep, voffB); PG8_STAGE(PG8_SA(0, 1), cA + hstep, voffA);
        if (wr == 1) PG8_BAR;
        PG8_WAIT_V(4); PG8_BAR;
        PG8_STAGE(PG8_SB(1, 0), cB + kstep, voffB); PG8_STAGE(PG8_SA(1, 0), cA + kstep, voffA); PG8_STAGE(PG8_SB(1, 1), cB + hstep + kstep, voffB);
        PG8_WAIT_V(6); PG8_BAR;
    }
    for (;;) {
        const bool has_next = S.next(ui + 1, nxt);
        const char* nA = has_next ? (const char*)g.A + (size_t)nxt.pm * tstep : cA; const char* nB = has_next ? (const char*)g.Bt + (size_t)nxt.pn * tstep : cB;
        for (int t = 0; t < nt; t += 2) {
            const bool last = (t == nt - 2);
            const char* a1 = cA + (size_t)(t + 1) * kstep;
            const char* a2 = last ? nA : cA + (size_t)(t + 2) * kstep; const char* b2 = last ? nB : cB + (size_t)(t + 2) * kstep;
            const char* a3 = a2 + kstep; const char* b3 = b2 + kstep;
            if (last && has_next) S.a_ready(nxt);
            if constexpr (SP2) {
            PG8_LDB(B0, 0, 0); PG8_LDB(B1, 0, 1); PG8_SCHED; PG8_LDA(At, 0, 0); PG8_STAGE(PG8_SA(1, 1), a1 + hstep, voffA);
            PG8_WAIT_V(8); PG8_WAIT_L(0); PG8_BAR; PG8_MMA(0, 0, At, B0); PG8_MMA(0, 1, At, B1); PG8_BAR; PG8_SCHED;
            PG8_LDA(At, 0, 1); PG8_STAGE(PG8_SB(0, 0), b2, voffB); PG8_STAGE(PG8_SB(0, 1), b2 + hstep, voffB); PG8_STAGE(PG8_SA(0, 0), a2, voffA);
            PG8_WAIT_V(8); PG8_WAIT_L(0); PG8_BAR; PG8_MMA(1, 0, At, B0); PG8_MMA(1, 1, At, B1); PG8_BAR; PG8_SCHED;
            PG8_LDB(B0, 1, 0); PG8_LDB(B1, 1, 1); PG8_SCHED; PG8_LDA(At, 1, 0); PG8_STAGE(PG8_SA(0, 1), a2 + hstep, voffA);
            PG8_WAIT_V(8); PG8_WAIT_L(0); PG8_BAR; PG8_MMA(0, 0, At, B0); PG8_MMA(0, 1, At, B1); PG8_BAR; PG8_SCHED;
            PG8_LDA(At, 1, 1); PG8_STAGE(PG8_SB(1, 0), b3, voffB); PG8_STAGE(PG8_SB(1, 1), b3 + hstep, voffB); PG8_STAGE(PG8_SA(1, 0), a3, voffA);
            PG8_WAIT_V(8); PG8_WAIT_L(0); PG8_BAR; PG8_MMA(1, 0, At, B0); PG8_MMA(1, 1, At, B1); PG8_BAR; PG8_SCHED;
            } else {
            PG8_LDB(B0, 0, 0); PG8_SCHED; PG8_LDA(At, 0, 0); PG8_STAGE(PG8_SA(1, 1), a1 + hstep, voffA);
            PG8_WAIT_L(8); PG8_BAR; PG8_WAIT_L(0); PG8_MMA(0, 0, At, B0); PG8_BAR; PG8_SCHED;
            PG8_LDB(B1, 0, 1); PG8_STAGE(PG8_SB(0, 0), b2, voffB);
            PG8_BAR; PG8_WAIT_L(0); PG8_MMA(0, 1, At, B1); PG8_BAR;
            PG8_LDA(At, 0, 1); PG8_STAGE(PG8_SA(0, 0), a2, voffA);
            PG8_BAR; PG8_WAIT_L(0); PG8_MMA(1, 0, At, B0); PG8_BAR; PG8_SCHED;
            PG8_STAGE(PG8_SB(0, 1), b2 + hstep, voffB);
            PG8_WAIT_V(6); PG8_BAR; PG8_MMA(1, 1, At, B1); PG8_BAR;
            PG8_LDB(B0, 1, 0); PG8_SCHED; PG8_LDA(At, 1, 0); PG8_STAGE(PG8_SA(0, 1), a2 + hstep, voffA);
            PG8_WAIT_L(8); PG8_BAR; PG8_WAIT_L(0); PG8_MMA(0, 0, At, B0); PG8_BAR; PG8_SCHED;
            PG8_LDB(B1, 1, 1); PG8_STAGE(PG8_SB(1, 0), b3, voffB);
            PG8_BAR; PG8_WAIT_L(0); PG8_MMA(0, 1, At, B1); PG8_BAR;
            PG8_LDA(At, 1, 1); PG8_STAGE(PG8_SA(1, 0), a3, voffA);
            PG8_BAR; PG8_WAIT_L(0); PG8_MMA(1, 0, At, B0); PG8_BAR; PG8_SCHED;
            PG8_STAGE(PG8_SB(1, 1), b3 + hstep, voffB);
            PG8_WAIT_V(6); PG8_BAR; PG8_MMA(1, 1, At, B1); PG8_BAR;
            }
        }
        if constexpr (ALIGN_EPI) { if (wr == 0) PG8_BAR; }
        if constexpr (!Epi::AFTER_DRAIN) { E(acc, cur, wr, wc, fr, fq); S.done(cur); }
        if (!has_next) break;
#pragma unroll
        for (int a = 0; a < 2; ++a)
#pragma unroll
            for (int b = 0; b < 2; ++b)
#pragma unroll
                for (int m = 0; m < 4; ++m)
#pragma unroll
                    for (int n = 0; n < 2; ++n) acc[a][b][m][n] = (f32x4){0.f, 0.f, 0.f, 0.f};
        cur = nxt; cA = nA; cB = nB; ++ui;
        if constexpr (ALIGN_EPI) { if (wr == 1) PG8_BAR; }
    }
    PG8_WAIT_V(0);
    if constexpr (!ALIGN_EPI) { if (wr == 0) PG8_BAR; }
    PG8_BAR;
    if constexpr (Epi::AFTER_DRAIN) { E.fused(acc, cur, wr, wc, fr, fq, lds, wid, lane); S.done(cur); }
#undef PG8_SA
#undef PG8_SB
#undef PG8_STAGE
#undef PG8_LDA
#undef PG8_LDB
#undef PG8_MMA
#undef PG8_WAIT_V
#undef PG8_WAIT_L
#undef PG8_BAR
#undef PG8_SCHED
}
}
#ifndef DI
#define DI __device__ __forceinline__
#endif
#define LAS __attribute__((address_space(3)))
typedef unsigned short bf16;
typedef float f32x2 __attribute__((ext_vector_type(2)));
typedef float f32x4 __attribute__((ext_vector_type(4)));
typedef float f32x16 __attribute__((ext_vector_type(16)));
typedef short bf16x8 __attribute__((ext_vector_type(8)));
typedef short s16x4 __attribute__((ext_vector_type(4)));
typedef unsigned u32x2 __attribute__((ext_vector_type(2)));
typedef unsigned u32x4 __attribute__((ext_vector_type(4)));
typedef __bf16 bf16x2_t __attribute__((ext_vector_type(2)));
DI unsigned cvtpk(float lo, float hi) { f32x2 v = {lo, hi}; bf16x2_t b = __builtin_convertvector(v, bf16x2_t); return __builtin_bit_cast(unsigned, b); }
DI float bf2f(bf16 b) { return __uint_as_float(((unsigned)b) << 16); }
DI float wave_sum(float v) {
#pragma unroll
    for (int o = 1; o < 64; o <<= 1) v += __shfl_xor(v, o);
    return v;
}
DI float fexp(float x) { return __builtin_amdgcn_exp2f(x * 1.4426950408889634f); }
DI float fsigmoid(float x) { return __builtin_amdgcn_rcpf(1.0f + fexp(-x)); }
DI f32x16 mfma32(bf16x8 a, bf16x8 b, f32x16 c) { return __builtin_amdgcn_mfma_f32_32x32x16_bf16(a, b, c, 0, 0, 0); }
DI bf16x8 pack8(const f32x16& x, int s) {
    u32x4 p;
    p[0] = cvtpk(x[8 * s + 0], x[8 * s + 1]); p[1] = cvtpk(x[8 * s + 2], x[8 * s + 3]);
    p[2] = cvtpk(x[8 * s + 4], x[8 * s + 5]); p[3] = cvtpk(x[8 * s + 6], x[8 * s + 7]);
    return __builtin_bit_cast(bf16x8, p);
}
DI bf16x8 cat4(s16x4 lo, s16x4 hi) { return __builtin_shufflevector(lo, hi, 0, 1, 2, 3, 4, 5, 6, 7); }

constexpr int D = 1024, TP = 4096, TSM = 8192, T = TP + TSM, FH = 2816, NMODE = 9 * D;
constexpr float EPS = 1e-6f;
constexpr size_t HM = 512u * 1024u;
constexpr size_t WS_MOD = 1 * HM;
constexpr size_t WS_FIN00 = 4 * HM, WS_FIN01 = 26 * HM, WS_FOUT00 = 48 * HM, WS_FOUT01 = 59 * HM, WS_AIN = 70 * HM, WS_AOUT = 82 * HM;
constexpr size_t WS_FIN10 = 86 * HM, WS_FOUT10 = 108 * HM, WS_HIN = 119 * HM, WS_FIN11 = 139 * HM, WS_FOUT11 = 161 * HM, WS_HOUT = 172 * HM;
constexpr size_t WS_H = 176 * HM;
constexpr size_t WS_Y = 224 * HM;
constexpr size_t WS_BIG = 320 * HM;
constexpr size_t WS_ACT = WS_BIG;
constexpr size_t WS_Q = WS_BIG, WS_K = WS_BIG + 48 * HM, WS_V = WS_K + 52 * HM;
constexpr size_t WS_HQ = WS_BIG, WS_HI = WS_BIG + 48 * HM, WS_HG = WS_BIG + 96 * HM, WS_LF = WS_BIG + 144 * HM;
constexpr size_t WS_LB = 4 * HM;
struct EpiF32 {
    static constexpr bool PERM = false, AFTER_DRAIN = false;
    float* C;
    DI void operator()(const f32x4 (&acc)[2][2][4][2], const pg8::Unit& u, int wr, int wc, int fr, int fq) const {
        const int row0 = u.pm * 256 + wr * 64 + fr, col0 = u.pn * 256 + wc * 32 + 4 * fq;
#pragma unroll
        for (int ai = 0; ai < 2; ++ai)
#pragma unroll
            for (int m = 0; m < 4; ++m) { float* rowp = C + (size_t)(row0 + ai * 128 + m * 16) * D + col0;
#pragma unroll
                for (int bj = 0; bj < 2; ++bj)
#pragma unroll
                    for (int n = 0; n < 2; ++n) *(f32x4*)(rowp + bj * 128 + n * 16) = acc[ai][bj][m][n]; }
    }
};
struct EpiSwiglu {
    static constexpr bool PERM = false, AFTER_DRAIN = false;
    bf16* O;
    DI void operator()(const f32x4 (&acc)[2][2][4][2], const pg8::Unit& u, int wr, int wc, int fr, int fq) const {
        const int row0 = u.pm * 256 + wr * 64 + fr, col0 = u.pn * 128 + wc * 32 + 4 * fq;
#pragma unroll
        for (int ai = 0; ai < 2; ++ai)
#pragma unroll
            for (int m = 0; m < 4; ++m) { bf16* rowp = O + (size_t)(row0 + ai * 128 + m * 16) * FH + col0;
#pragma unroll
                for (int n = 0; n < 2; ++n) { const f32x4 a = acc[ai][0][m][n], b = acc[ai][1][m][n]; float r[4];
#pragma unroll
                    for (int j = 0; j < 4; ++j) r[j] = a[j] * fsigmoid(a[j]) * b[j];
                    u32x2 w; w.x = cvtpk(r[0], r[1]); w.y = cvtpk(r[2], r[3]); *(u32x2*)(rowp + n * 16) = w; } }
    }
};
constexpr float QSCALE = 0.125f * 1.4426950408889634f;
struct EpiQKV {
    static constexpr bool PERM = false, AFTER_DRAIN = false;
    bf16 *Qb, *Kb, *Vb; float *nck, *ncv;
    DI void operator()(const f32x4 (&acc)[2][2][4][2], const pg8::Unit& u, int wr, int wc, int fr, int fq) const {
        const int sec = u.pn >> 2; const bool sample = u.pm >= 16;
        const int row0 = u.pm * 256 + wr * 64 + fr, col0 = (u.pn & 3) * 256 + wc * 32 + 4 * fq;
        if (sec == 2) {
#pragma unroll
            for (int ai = 0; ai < 2; ++ai)
#pragma unroll
                for (int m = 0; m < 4; ++m) { const size_t off = (size_t)(row0 + ai * 128 + m * 16) * D + col0;
#pragma unroll
                    for (int bj = 0; bj < 2; ++bj)
#pragma unroll
                        for (int n = 0; n < 2; ++n) { const f32x4 v = acc[ai][bj][m][n]; u32x2 w; w.x = cvtpk(v[0], v[1]); w.y = cvtpk(v[2], v[3]);
                            *(u32x2*)(Vb + off + bj * 128 + n * 16) = w; if (!sample) *(f32x4*)(ncv + off + bj * 128 + n * 16) = v; } }
        } else {
            float inv[4];
#pragma unroll
            for (int j = 0; j < 4; ++j) inv[j] = __builtin_amdgcn_exp2f(-(float)(4 * fq + j) * (13.287712379549449f / 16.0f)) * 0.15915494309189535f;
            const int axis = wc & 1;
            bf16* dst = sec == 0 ? Qb : Kb; const float sc = sec == 0 ? QSCALE : 1.0f;
#pragma unroll
            for (int ai = 0; ai < 2; ++ai)
#pragma unroll
                for (int m = 0; m < 4; ++m) { const int row = row0 + ai * 128 + m * 16; const size_t off = (size_t)row * D + col0;
                    const int t = (row - TP) & 2047; const float pos = (float)(axis ? (t & 63) : (t >> 6));
                    float cs[4], sn[4];
#pragma unroll
                    for (int j = 0; j < 4; ++j) { const float rev = __builtin_amdgcn_fractf(pos * inv[j]); cs[j] = sample ? __builtin_amdgcn_cosf(rev) : 1.0f; sn[j] = sample ? __builtin_amdgcn_sinf(rev) : 0.0f; }
#pragma unroll
                    for (int bj = 0; bj < 2; ++bj) { const f32x4 x1 = acc[ai][bj][m][0], x2 = acc[ai][bj][m][1]; f32x4 o1, o2;
#pragma unroll
                        for (int j = 0; j < 4; ++j) { o1[j] = x1[j] * cs[j] - x2[j] * sn[j]; o2[j] = x1[j] * sn[j] + x2[j] * cs[j]; }
                        if (sec == 1 && !sample) { *(f32x4*)(nck + off + bj * 128) = o1; *(f32x4*)(nck + off + bj * 128 + 16) = o2; }
                        u32x2 w1, w2; w1.x = cvtpk(o1[0] * sc, o1[1] * sc); w1.y = cvtpk(o1[2] * sc, o1[3] * sc); w2.x = cvtpk(o2[0] * sc, o2[1] * sc); w2.y = cvtpk(o2[2] * sc, o2[3] * sc);
                        *(u32x2*)(dst + off + bj * 128) = w1; *(u32x2*)(dst + off + bj * 128 + 16) = w2; } }
        }
    }
};
struct EpiHgrn {
    static constexpr bool PERM = false, AFTER_DRAIN = false;
    bf16 *HQ, *HI, *HG; float *LF, *LB; const float* hlb;
    DI void operator()(const f32x4 (&acc)[2][2][4][2], const pg8::Unit& u, int wr, int wc, int fr, int fq) const {
        const int sec = u.pn >> 2;
        const int row0 = u.pm * 256 + wr * 64 + fr, col0 = (u.pn & 3) * 256 + wc * 32 + 4 * fq;
        if (sec == 1 || sec == 2) {
            const int dir = sec - 1; float* L = dir ? LB : LF;
#pragma unroll
            for (int bj = 0; bj < 2; ++bj)
#pragma unroll
                for (int n = 0; n < 2; ++n) { const int col = col0 + bj * 128 + n * 16;
                    const f32x4 p0 = *(const f32x4*)(hlb + dir * 1024 + col), p1 = *(const f32x4*)(hlb + 2048 + dir * 1024 + col); float lb[4];
#pragma unroll
                    for (int j = 0; j < 4; ++j) lb[j] = __builtin_amdgcn_rcpf(1.0f + fexp(p0[j] - p1[j]));
#pragma unroll
                    for (int ai = 0; ai < 2; ++ai)
#pragma unroll
                        for (int m = 0; m < 4; ++m) { const f32x4 z = acc[ai][bj][m][n]; f32x4 o;
#pragma unroll
                            for (int j = 0; j < 4; ++j) { const float f = lb[j] + (1.0f - lb[j]) * fsigmoid(z[j]); o[j] = __builtin_amdgcn_logf(f) * 0.6931471805599453f; }
                            *(f32x4*)(L + (size_t)(row0 + ai * 128 + m * 16) * D + col) = o; } }
        } else {
            bf16* dst = HQ + (size_t)(sec == 0 ? 0 : sec - 2) * ((size_t)T * D);
#pragma unroll
            for (int ai = 0; ai < 2; ++ai)
#pragma unroll
                for (int m = 0; m < 4; ++m) { const size_t off = (size_t)(row0 + ai * 128 + m * 16) * D + col0;
#pragma unroll
                    for (int bj = 0; bj < 2; ++bj)
#pragma unroll
                        for (int n = 0; n < 2; ++n) { const f32x4 v = acc[ai][bj][m][n]; u32x2 w; w.x = cvtpk(v[0], v[1]); w.y = cvtpk(v[2], v[3]); *(u32x2*)(dst + off + bj * 128 + n * 16) = w; } }
        }
    }
};
DI void transpose_item(const float* W, int K, int N, bf16* WT, bool swig, LAS float* scr, int item, int lane) {
    const int nblk = N / 32, kb = item / nblk, nb = item % nblk, k0 = 64 * kb, n0 = 32 * nb;
    int r0 = n0;
    if (swig) { const int bj = n0 >= FH ? 1 : 0, uu = n0 - bj * FH; r0 = 256 * (uu >> 7) + 128 * bj + (uu & 127); }
#pragma unroll 8
    for (int i = 0; i < 32; ++i) { const int kk = 2 * i + (lane >> 5); scr[kk * 33 + (lane & 31)] = W[(size_t)(k0 + kk) * N + n0 + (lane & 31)]; }
    asm volatile("s_waitcnt lgkmcnt(0)" ::: "memory");
    const int c = lane & 7;
#pragma unroll
    for (int j = 0; j < 4; ++j) { const int n = (lane >> 3) + 8 * j; const LAS float* s = scr + (8 * c) * 33 + n;
        u32x4 o; o.x = cvtpk(s[0 * 33], s[1 * 33]); o.y = cvtpk(s[2 * 33], s[3 * 33]); o.z = cvtpk(s[4 * 33], s[5 * 33]); o.w = cvtpk(s[6 * 33], s[7 * 33]);
        *(u32x4*)(WT + (size_t)(r0 + n) * K + k0 + 8 * c) = o; }
    asm volatile("s_waitcnt lgkmcnt(0)" ::: "memory");
}

DI void norm_phase(const float* xp, const float* xs, const float* Y, float* X, bf16* H,
                   const float* modpost, int jpost, const float* gpost, float resw,
                   const float* modpre, int jpre, const float* gpre, int gw, int NGW, int lane) {
    for (int row = gw; row < T; row += NGW) {
        const int mi = row < TP ? 0 : 1 + ((row - TP) >> 11);
        const float* xr = row < TP ? xp + (size_t)row * D : xs + (size_t)(row - TP) * D;
        f32x4 v[4];
#pragma unroll
        for (int j = 0; j < 4; ++j) v[j] = *(const f32x4*)(xr + 4 * lane + 256 * j);
        if (Y) {
            f32x4 y[4]; float s = 0.f;
#pragma unroll
            for (int j = 0; j < 4; ++j) { y[j] = *(const f32x4*)(Y + (size_t)row * D + 4 * lane + 256 * j); s += (y[j].x * y[j].x + y[j].y * y[j].y) + (y[j].z * y[j].z + y[j].w * y[j].w); }
            const float rstd = __builtin_amdgcn_rsqf(wave_sum(s) * (1.0f / D) + EPS) * resw;
            const float* gate = modpost + (size_t)mi * NMODE + (3 * jpost + 2) * D;
#pragma unroll
            for (int j = 0; j < 4; ++j) { const f32x4 gt = *(const f32x4*)(gate + 4 * lane + 256 * j), gg = *(const f32x4*)(gpost + 4 * lane + 256 * j);
                v[j] = v[j] + gt * (y[j] * rstd) * gg; }
        }
#pragma unroll
        for (int j = 0; j < 4; ++j) *(f32x4*)(X + (size_t)row * D + 4 * lane + 256 * j) = v[j];
        if (H) {
            float s = 0.f;
#pragma unroll
            for (int j = 0; j < 4; ++j) s += (v[j].x * v[j].x + v[j].y * v[j].y) + (v[j].z * v[j].z + v[j].w * v[j].w);
            const float rstd = __builtin_amdgcn_rsqf(wave_sum(s) * (1.0f / D) + EPS);
            const float* sh = modpre + (size_t)mi * NMODE + (3 * jpre) * D; const float* sc = sh + D;
#pragma unroll
            for (int j = 0; j < 4; ++j) { const f32x4 a = *(const f32x4*)(sh + 4 * lane + 256 * j), b = *(const f32x4*)(sc + 4 * lane + 256 * j), gg = *(const f32x4*)(gpre + 4 * lane + 256 * j);
                const f32x4 h = (v[j] * rstd * gg) * (b + 1.0f) + a;
                u32x2 w; w.x = cvtpk(h.x, h.y); w.y = cvtpk(h.z, h.w); *(u32x2*)(H + (size_t)row * D + 4 * lane + 256 * j) = w; }
        }
    }
}

constexpr int AK_STRIDE = 272, AV_STRIDE = 136, AK_BYTES = 64 * AK_STRIDE, AV_BYTES = 128 * AV_STRIDE;
DI void attn_phase(LAS unsigned char* lds, const bf16* Qb, const bf16* Kb, const bf16* Vb, bf16* OB, const float* lamp, const float* subln) {
    int tid_ = threadIdx.x; asm volatile("" : "+v"(tid_));
    const int tid = tid_, lane = tid & 63, w = __builtin_amdgcn_readfirstlane(tid >> 6), r = lane & 31, h = lane >> 5;
    const int qg = w >> 1, c = w & 1;
    float lam;
    { const float a = lamp[lane] * lamp[64 + lane], b = lamp[128 + lane] * lamp[192 + lane];
      lam = fexp(wave_sum(a)) - fexp(wave_sum(b)) + 0.2f; }
    const float OUTSC = 0.8f;
    for (int u = blockIdx.x; u < 768; u += gridDim.x) {
        int qrow0, krow0, krow1, nt, nt0, head;
        if (u < 512) { const int b = u >> 7; head = (u >> 4) & 7; const int qb = u & 15; qrow0 = TP + b * 2048 + qb * 128; krow0 = TP + b * 2048; krow1 = T + b * 256; nt0 = 32; nt = 36; }
        else { const int pu = u - 512, b = pu >> 4; head = (pu >> 1) & 7; qrow0 = b * 256 + (pu & 1) * 128; krow0 = b * 256; krow1 = 0; nt0 = 4; nt = 4; }
        const int qrow = qrow0 + 32 * qg + r;
        bf16x8 qf[4];
#pragma unroll
        for (int kk = 0; kk < 4; ++kk) qf[kk] = *(const bf16x8*)(Qb + (size_t)qrow * D + head * 128 + c * 64 + 16 * kk + 8 * h);
        f32x16 O[4];
#pragma unroll
        for (int vt = 0; vt < 4; ++vt)
#pragma unroll
            for (int i = 0; i < 16; ++i) O[vt][i] = 0.f;
        float mrun = -1e30f, lrun = 0.f;
        const int kkey = tid >> 3, kch = tid & 7, vkey = tid & 63, vch = tid >> 6;
        u32x4 kr0, kr1, vr0, vr1;
#define ATT_LOAD(tt) do { const int _t = (tt); const size_t _rowk = (size_t)(_t < nt0 ? krow0 + 64 * _t : krow1 + 64 * (_t - nt0)); \
            const bf16* _kp = Kb + (_rowk + kkey) * D + head * 128 + kch * 16; kr0 = *(const u32x4*)_kp; kr1 = *(const u32x4*)(_kp + 8); \
            const bf16* _vp = Vb + (_rowk + vkey) * D + head * 128 + vch * 16; vr0 = *(const u32x4*)_vp; vr1 = *(const u32x4*)(_vp + 8); } while (0)
#define ATT_STORE(bufi) do { LAS unsigned char* _kb = lds + (bufi) * (AK_BYTES + AV_BYTES); LAS unsigned char* _vb = _kb + AK_BYTES; \
            *(LAS u32x4*)(_kb + kkey * AK_STRIDE + kch * 32) = kr0; *(LAS u32x4*)(_kb + kkey * AK_STRIDE + kch * 32 + 16) = kr1; \
            _Pragma("unroll") for (int _e = 0; _e < 4; ++_e) { \
                *(LAS unsigned short*)(_vb + (vch * 16 + 2 * _e) * AV_STRIDE + vkey * 2) = (unsigned short)(vr0[_e] & 0xffffu); \
                *(LAS unsigned short*)(_vb + (vch * 16 + 2 * _e + 1) * AV_STRIDE + vkey * 2) = (unsigned short)(vr0[_e] >> 16); \
                *(LAS unsigned short*)(_vb + (vch * 16 + 8 + 2 * _e) * AV_STRIDE + vkey * 2) = (unsigned short)(vr1[_e] & 0xffffu); \
                *(LAS unsigned short*)(_vb + (vch * 16 + 8 + 2 * _e + 1) * AV_STRIDE + vkey * 2) = (unsigned short)(vr1[_e] >> 16); } } while (0)
        ATT_LOAD(0); ATT_STORE(0);
        __syncthreads();
        for (int t = 0; t < nt; ++t) {
            if (t + 1 < nt) ATT_LOAD(t + 1);
            const LAS unsigned char* kb = lds + (t & 1) * (AK_BYTES + AV_BYTES); const LAS unsigned char* vb = kb + AK_BYTES;
#pragma unroll
            for (int sub = 0; sub < 2; ++sub) {
                f32x16 s;
#pragma unroll
                for (int i = 0; i < 16; ++i) s[i] = 0.f;
#pragma unroll
                for (int kk = 0; kk < 4; ++kk) { const bf16x8 ka = *(const LAS bf16x8*)(kb + (32 * sub + r) * AK_STRIDE + c * 128 + kk * 32 + h * 16);
                    s = mfma32(ka, qf[kk], s); }
                float mx = s[0];
#pragma unroll
                for (int i = 1; i < 16; ++i) mx = fmaxf(mx, s[i]);
                mx = fmaxf(mx, __shfl_xor(mx, 32));
                const float mnew = fmaxf(mrun, mx), alpha = __builtin_amdgcn_exp2f(mrun - mnew);
                mrun = mnew;
                float ps = 0.f;
#pragma unroll
                for (int i = 0; i < 16; ++i) { s[i] = __builtin_amdgcn_exp2f(s[i] - mnew); ps += s[i]; }
                lrun = lrun * alpha + ps;
                if (__any(alpha != 1.0f)) {
#pragma unroll
                    for (int vt = 0; vt < 4; ++vt)
#pragma unroll
                        for (int i = 0; i < 16; ++i) O[vt][i] *= alpha;
                }
                const bf16x8 pf0 = pack8(s, 0), pf1 = pack8(s, 1);
#pragma unroll
                for (int vt = 0; vt < 4; ++vt) {
                    const LAS unsigned char* vp = vb + (32 * vt + r) * AV_STRIDE + (32 * sub + 4 * h) * 2;
                    O[vt] = mfma32(cat4(*(const LAS s16x4*)vp, *(const LAS s16x4*)(vp + 16)), pf0, O[vt]);
                    O[vt] = mfma32(cat4(*(const LAS s16x4*)(vp + 32), *(const LAS s16x4*)(vp + 48)), pf1, O[vt]);
                }
            }
            if (t + 1 < nt) ATT_STORE((t + 1) & 1);
            __syncthreads();
        }
#undef ATT_LOAD
#undef ATT_STORE
        LAS float* ex = (LAS float*)lds;
        { const float lt = lrun + __shfl_xor(lrun, 32); const float il = __builtin_amdgcn_rcpf(lt);
#pragma unroll
          for (int vt = 0; vt < 4; ++vt)
#pragma unroll
              for (int i = 0; i < 16; ++i) O[vt][i] *= il; }
        if (c == 1) {
#pragma unroll
            for (int vt = 0; vt < 4; ++vt)
#pragma unroll
                for (int i = 0; i < 16; ++i) { const int v = 32 * vt + (i & 3) + 8 * (i >> 2) + 4 * h; ex[(qg * 128 + v) * 32 + r] = O[vt][i]; }
        }
        __syncthreads();
        if (c == 0) {
            float ssq = 0.f;
#pragma unroll
            for (int vt = 0; vt < 4; ++vt)
#pragma unroll
                for (int i = 0; i < 16; ++i) { const int v = 32 * vt + (i & 3) + 8 * (i >> 2) + 4 * h; const float o = O[vt][i] - lam * ex[(qg * 128 + v) * 32 + r]; O[vt][i] = o; ssq += o * o; }
            ssq += __shfl_xor(ssq, 32);
            const float rstd = __builtin_amdgcn_rsqf(ssq * (1.0f / 128.0f) + EPS) * OUTSC;
            bf16* orow = OB + (size_t)qrow * D + head * 128;
#pragma unroll
            for (int vt = 0; vt < 4; ++vt)
#pragma unroll
                for (int g4 = 0; g4 < 4; ++g4) { const int v = 32 * vt + 8 * g4 + 4 * h; const f32x4 gn = *(const f32x4*)(subln + v);
                    u32x2 wv; wv.x = cvtpk(O[vt][4 * g4] * rstd * gn.x, O[vt][4 * g4 + 1] * rstd * gn.y); wv.y = cvtpk(O[vt][4 * g4 + 2] * rstd * gn.z, O[vt][4 * g4 + 3] * rstd * gn.w);
                    *(u32x2*)(orow + v) = wv; }
        }
        __syncthreads();
    }
}

constexpr int SQ_STRIDE = 272, ST_STRIDE = 80;
constexpr int SG_QH = 0, SG_KH = 32 * SQ_STRIDE, SG_KT = 2 * 32 * SQ_STRIDE, SG_VT = SG_KT + 128 * ST_STRIDE, SG_DL = SG_VT + 128 * ST_STRIDE, SG_SSQ = SG_DL + 512, SG_BYTES = SG_SSQ + 512;
DI void scan_phase(LAS unsigned char* lds, const bf16* HQ, const bf16* HI, const bf16* HG, const float* LF, const float* LB, float* OS, bf16* OB,
                   const float* st_in, float* st_out, const float* gnorm) {
    int tid_ = threadIdx.x; asm volatile("" : "+v"(tid_));
    const int tid = tid_, lane = tid & 63, w = __builtin_amdgcn_readfirstlane(tid >> 6), r = lane & 31, h = lane >> 5;
    const int g = w >> 2, ws = w & 3, tg = tid & 255, kc = tg >> 1, th = tg & 1;
    LAS unsigned char* gl = lds + g * SG_BYTES;
    const float* LG = g ? LB : LF;
    for (int item = blockIdx.x; item < 160; item += gridDim.x) {
        int row0, L, head, b; bool sample;
        if (item < 32) { b = item >> 3; head = item & 7; row0 = TP + b * 2048; L = 2048; sample = true; }
        else { const int pi = item - 32; b = pi >> 3; head = pi & 7; row0 = b * 256; L = 256; sample = false; }
        const int nc = L / 32;
        const size_t cbase = (size_t)row0 * D + head * 128;
        const float* LGb = LG + cbase; const bf16* HQb = HQ + cbase; const bf16* HIb = HI + cbase;
        f32x16 S[4];
        if (sample) { const float* sp = st_in + (size_t)((b * 2 + g) * 8 + head) * 16384 + 32 * ws + r;
#pragma unroll
            for (int Tt = 0; Tt < 4; ++Tt)
#pragma unroll
                for (int i = 0; i < 16; ++i) S[Tt][i] = sp[(32 * Tt + (i & 3) + 8 * (i >> 2) + 4 * h) * 128];
        } else {
#pragma unroll
            for (int Tt = 0; Tt < 4; ++Tt)
#pragma unroll
                for (int i = 0; i < 16; ++i) S[Tt][i] = 0.f;
        }
        float la[16]; unsigned qv2[8], iv2[8];
#define SC_TOK(cc, t) (g ? (L - 1 - (32 * (cc) + (t))) : (32 * (cc) + (t)))
#define SC_LOAD(cc) do { _Pragma("unroll") for (int _t = 0; _t < 16; ++_t) la[_t] = LGb[(unsigned)(SC_TOK(cc, 16 * th + _t) * D + kc)]; \
            _Pragma("unroll") for (int _t = 0; _t < 16; _t += 2) { const unsigned _o0 = (unsigned)(SC_TOK(cc, 16 * th + _t) * D + kc), _o1 = (unsigned)(SC_TOK(cc, 16 * th + _t + 1) * D + kc); \
                qv2[_t >> 1] = (unsigned)HQb[_o0] | ((unsigned)HQb[_o1] << 16); iv2[_t >> 1] = (unsigned)HIb[_o0] | ((unsigned)HIb[_o1] << 16); } } while (0)
        SC_LOAD(0);
        for (int s = 0; s < nc; ++s) {
            float suma = 0.f;
#pragma unroll
            for (int t = 0; t < 16; ++t) suma += la[t];
            const float sumo = __shfl_xor(suma, 1), blast = suma + sumo;
            float bb = th ? sumo : 0.f;
            unsigned ktp[8], vtp[8];
#pragma unroll
            for (int tt = 0; tt < 16; tt += 2) {
                float ktv[2];
#pragma unroll
                for (int e = 0; e < 2; ++e) {
                    const float lft = la[tt + e];
                    bb += lft;
                    const float kk = 1.0f - fexp(lft);
                    const float qh = __uint_as_float(e ? (qv2[tt >> 1] & 0xffff0000u) : (qv2[tt >> 1] << 16)) * fexp(fmaxf(bb, -80.0f)), kh = kk * fexp(fminf(-bb, 80.0f));
                    ktv[e] = kk * fexp(blast - bb);
                    const int t = 16 * th + tt + e;
                    *(LAS unsigned short*)(gl + SG_QH + t * SQ_STRIDE + kc * 2) = (unsigned short)(cvtpk(qh, 0.f) & 0xffffu);
                    *(LAS unsigned short*)(gl + SG_KH + t * SQ_STRIDE + kc * 2) = (unsigned short)(cvtpk(kh, 0.f) & 0xffffu);
                }
                ktp[tt >> 1] = cvtpk(ktv[0], ktv[1]);
                vtp[tt >> 1] = iv2[tt >> 1];
            }
            { u32x4 a, bq; a.x = ktp[0]; a.y = ktp[1]; a.z = ktp[2]; a.w = ktp[3]; bq.x = ktp[4]; bq.y = ktp[5]; bq.z = ktp[6]; bq.w = ktp[7];
              *(LAS u32x4*)(gl + SG_KT + kc * ST_STRIDE + th * 32) = a; *(LAS u32x4*)(gl + SG_KT + kc * ST_STRIDE + th * 32 + 16) = bq;
              a.x = vtp[0]; a.y = vtp[1]; a.z = vtp[2]; a.w = vtp[3]; bq.x = vtp[4]; bq.y = vtp[5]; bq.z = vtp[6]; bq.w = vtp[7];
              *(LAS u32x4*)(gl + SG_VT + kc * ST_STRIDE + th * 32) = a; *(LAS u32x4*)(gl + SG_VT + kc * ST_STRIDE + th * 32 + 16) = bq; }
            if (th == 0) *(LAS float*)(gl + SG_DL + kc * 4) = fexp(blast);
            __syncthreads();
            if (s + 1 < nc) SC_LOAD(s + 1);
            f32x16 at;
#pragma unroll
            for (int i = 0; i < 16; ++i) at[i] = 0.f;
#pragma unroll
            for (int kk = 0; kk < 8; ++kk) { const bf16x8 ka = *(const LAS bf16x8*)(gl + SG_KH + r * SQ_STRIDE + kk * 32 + h * 16), qb = *(const LAS bf16x8*)(gl + SG_QH + r * SQ_STRIDE + kk * 32 + h * 16);
                at = mfma32(ka, qb, at); }
#pragma unroll
            for (int i = 0; i < 16; ++i) { const int srow = (i & 3) + 8 * (i >> 2) + 4 * h; at[i] = srow > r ? 0.f : at[i]; }
            f32x16 o;
#pragma unroll
            for (int i = 0; i < 16; ++i) o[i] = 0.f;
#pragma unroll
            for (int jj = 0; jj < 2; ++jj) { const LAS unsigned char* vp = gl + SG_VT + (32 * ws + r) * ST_STRIDE + (16 * jj + 4 * h) * 2;
                o = mfma32(cat4(*(const LAS s16x4*)vp, *(const LAS s16x4*)(vp + 16)), pack8(at, jj), o); }
#pragma unroll
            for (int Tt = 0; Tt < 4; ++Tt)
#pragma unroll
                for (int jj = 0; jj < 2; ++jj) { const LAS unsigned char* qp = gl + SG_QH + r * SQ_STRIDE + (32 * Tt + 16 * jj + 4 * h) * 2;
                    o = mfma32(pack8(S[Tt], jj), cat4(*(const LAS s16x4*)qp, *(const LAS s16x4*)(qp + 16)), o); }
#pragma unroll
            for (int Tt = 0; Tt < 4; ++Tt) {
#pragma unroll
                for (int g4 = 0; g4 < 4; ++g4) { const f32x4 dl = *(const LAS f32x4*)(gl + SG_DL + (32 * Tt + 8 * g4 + 4 * h) * 4);
                    S[Tt][4 * g4] *= dl.x; S[Tt][4 * g4 + 1] *= dl.y; S[Tt][4 * g4 + 2] *= dl.z; S[Tt][4 * g4 + 3] *= dl.w; }
#pragma unroll
                for (int jj = 0; jj < 2; ++jj) { const bf16x8 ka = *(const LAS bf16x8*)(gl + SG_KT + (32 * Tt + r) * ST_STRIDE + (16 * jj + 8 * h) * 2), vbq = *(const LAS bf16x8*)(gl + SG_VT + (32 * ws + r) * ST_STRIDE + (16 * jj + 8 * h) * 2);
                    S[Tt] = mfma32(ka, vbq, S[Tt]); }
            }
            const size_t obase = cbase + (size_t)SC_TOK(s, r) * D + 32 * ws + 4 * h;
            const bool second = (2 * s >= nc);
            if (!second) {
#pragma unroll
                for (int g4 = 0; g4 < 4; ++g4) { f32x4 v; v.x = o[4 * g4]; v.y = o[4 * g4 + 1]; v.z = o[4 * g4 + 2]; v.w = o[4 * g4 + 3]; *(f32x4*)(OS + obase + 8 * g4) = v; }
            } else {
                float ssq = 0.f;
#pragma unroll
                for (int g4 = 0; g4 < 4; ++g4) { const f32x4 p = *(const f32x4*)(OS + obase + 8 * g4);
                    o[4 * g4] += p.x; o[4 * g4 + 1] += p.y; o[4 * g4 + 2] += p.z; o[4 * g4 + 3] += p.w;
                    ssq += (o[4 * g4] * o[4 * g4] + o[4 * g4 + 1] * o[4 * g4 + 1]) + (o[4 * g4 + 2] * o[4 * g4 + 2] + o[4 * g4 + 3] * o[4 * g4 + 3]); }
                ssq += __shfl_xor(ssq, 32);
                if (h == 0) *(LAS float*)(gl + SG_SSQ + (r * 4 + ws) * 4) = ssq;
                __syncthreads();
                const f32x4 sq = *(const LAS f32x4*)(gl + SG_SSQ + r * 16);
                const float rstd = __builtin_amdgcn_rsqf(((sq.x + sq.y) + (sq.z + sq.w)) * (1.0f / 128.0f) + EPS);
#pragma unroll
                for (int g4 = 0; g4 < 4; ++g4) { const u32x2 gg = *(const u32x2*)(HG + obase + 8 * g4); const f32x4 gn = *(const f32x4*)(gnorm + 32 * ws + 4 * h + 8 * g4);
                    const float g0 = __uint_as_float(gg.x << 16), g1 = __uint_as_float(gg.x & 0xffff0000u), g2 = __uint_as_float(gg.y << 16), g3 = __uint_as_float(gg.y & 0xffff0000u);
                    u32x2 wv; wv.x = cvtpk(o[4 * g4] * rstd * gn.x * fsigmoid(g0), o[4 * g4 + 1] * rstd * gn.y * fsigmoid(g1));
                    wv.y = cvtpk(o[4 * g4 + 2] * rstd * gn.z * fsigmoid(g2), o[4 * g4 + 3] * rstd * gn.w * fsigmoid(g3));
                    *(u32x2*)(OB + obase + 8 * g4) = wv; }
            }
            asm volatile("s_waitcnt vmcnt(0)" ::: "memory");
            __syncthreads();
        }
#undef SC_LOAD
        if (!sample) { float* sp = st_out + (size_t)((b * 2 + g) * 8 + head) * 16384 + 32 * ws + r;
#pragma unroll
            for (int Tt = 0; Tt < 4; ++Tt)
#pragma unroll
                for (int i = 0; i < 16; ++i) sp[(32 * Tt + (i & 3) + 8 * (i >> 2) + 4 * h) * 128] = S[Tt][i];
        }
    }
#undef SC_TOK
}

#define GAS __attribute__((address_space(1)))
#define XB_TMO      128
#define XB_XCNT(j)  (256  + 64 * (j))
#define XB_XSUB(j)  (1280 + 64 * (j))
#define XB_XGEN(j)  (2304 + 64 * (j))
#define XB_TOP      3328
#define XB_TOPGEN   3392
#define XCD_BAR_WORDS 3456
#define XB_SPIN_CAP (1u << 18)

__device__ __forceinline__ unsigned xb_ld(unsigned* p)              { return __hip_atomic_load(p, __ATOMIC_RELAXED, __HIP_MEMORY_SCOPE_AGENT); }
__device__ __forceinline__ unsigned xb_add(unsigned* p, unsigned v) { return __hip_atomic_fetch_add(p, v, __ATOMIC_RELAXED, __HIP_MEMORY_SCOPE_AGENT); }
__device__ __forceinline__ unsigned xb_xcc_id() { return (unsigned)__builtin_amdgcn_s_getreg((3 << 11) | 20) & 0xFu; }
#define XB_SPIN(cond, bar) do { unsigned _sp = 0; while (cond) { __builtin_amdgcn_s_sleep(1); \
    if ((++_sp & 255u) == 0u) { if (xb_ld(&(bar)[XB_TMO])) break; if (_sp > XB_SPIN_CAP) { atomicAdd(&(bar)[XB_TMO], 1u); break; } } } } while (0)

struct XcdBarrier {
    unsigned* bar; unsigned x;
    volatile LAS unsigned* st;
};

__device__ __forceinline__ XcdBarrier xcd_barrier_post(unsigned* bar, volatile LAS unsigned* st) {
    XcdBarrier b; b.bar = bar; b.x = xb_xcc_id(); b.st = st;
    if (threadIdx.x == 0) (void)xb_add(&bar[XB_XCNT(b.x)], 1u);
    return b;
}
__device__ __forceinline__ void xcd_barrier_complete(unsigned* bar, unsigned x, unsigned& nloc, unsigned& nx) {
    const unsigned G = gridDim.x * gridDim.y * gridDim.z;
    unsigned sum, cnt, mine, sp = 0u;
    for (;;) {
        sum = 0u; cnt = 0u; mine = 0u;
#pragma unroll
        for (unsigned j = 0; j < 16; ++j) { const unsigned c = xb_ld(&bar[XB_XCNT(j)]); sum += c; cnt += (c > 0u) ? 1u : 0u; mine = (j == x) ? c : mine; }
        if (sum == G) break;
        __builtin_amdgcn_s_sleep(1);
        if ((++sp & 255u) == 0u) { if (xb_ld(&bar[XB_TMO])) break; if (sp > XB_SPIN_CAP) { atomicAdd(&bar[XB_TMO], 1u); break; } }
    }
    nloc = mine > 0u ? mine : 1u; nx = cnt > 0u ? cnt : 1u;
}

__device__ __forceinline__ void xcd_barrier(const XcdBarrier& b) {
    asm volatile("s_waitcnt vmcnt(0)" ::: "memory");
    __syncthreads();
    if (threadIdx.x == 0) {
        unsigned* bar = b.bar;
        __builtin_amdgcn_s_waitcnt(0);
        unsigned nloc = b.st[0], nx = b.st[1];
        if (nloc == 0u) { xcd_barrier_complete(bar, b.x, nloc, nx); b.st[0] = nloc; b.st[1] = nx; }
        const unsigned old = xb_add(&bar[XB_XSUB(b.x)], 1u);
        const unsigned gen = old / nloc;
        if (old + 1u == (gen + 1u) * nloc) {
            __builtin_amdgcn_fence(__ATOMIC_RELEASE, "agent");
            asm volatile("s_waitcnt vmcnt(0)" ::: "memory");
            const unsigned og = xb_add(&bar[XB_TOP], 1u);
            const unsigned tg = og / nx;
            if (og + 1u == (tg + 1u) * nx) xb_add(&bar[XB_TOPGEN], 1u);
            else XB_SPIN(xb_ld(&bar[XB_TOPGEN]) == tg, bar);
            __builtin_amdgcn_fence(__ATOMIC_ACQUIRE, "agent");
            xb_add(&bar[XB_XGEN(b.x)], 1u);
            asm volatile("s_waitcnt vmcnt(0)" ::: "memory");
        } else {
            XB_SPIN(xb_ld(&bar[XB_XGEN(b.x)]) == gen, bar);
            __builtin_amdgcn_fence(__ATOMIC_ACQUIRE, "agent");
            asm volatile("s_waitcnt vmcnt(0)" ::: "memory");
        }
    }
    __syncthreads();
}


struct Args {
    const float *xp, *xs, *cache_k, *cache_v, *state, *c, *cctx, *wmod, *bmod, *normg, *ffn_in, *ffn_out, *attn_in, *attn_out, *attn_lam, *attn_subln, *hgrn_in, *hgrn_out, *hgrn_lb, *hgrn_gn;
    float* out; unsigned char* ws;
};
constexpr int LDS_BYTES = 147456, MISC_OFF = 131072 + 320;
constexpr size_t OUT_NCK = (size_t)T * D, OUT_NCV = OUT_NCK + (size_t)TP * D, OUT_ST = OUT_NCV + (size_t)TP * D;

typedef const __attribute__((address_space(4))) Args* KArgs;
#define KA() ({ KArgs _p = (KArgs)__builtin_amdgcn_kernarg_segment_ptr(); asm volatile("" : "+s"(_p)); _p; })
__global__ void __launch_bounds__(512) fwd_kernel(Args a_unused) {
    extern __shared__ __attribute__((aligned(16))) unsigned char lds_raw[];
    LAS unsigned char* lds = (LAS unsigned char*)lds_raw;
    cg::grid_group grid = cg::this_grid();
    const int G = gridDim.x;
    if (threadIdx.x < 64) ((volatile LAS unsigned*)(lds + MISC_OFF))[threadIdx.x] = 0u;
    __syncthreads();
    const XcdBarrier xbar = xcd_barrier_post((unsigned*)KA()->ws, (volatile LAS unsigned*)(lds + MISC_OFF) + 8);
#define TIDV() ({ int _t = threadIdx.x; asm volatile("" : "+v"(_t)); _t; })

    for (int rep = 0; rep < REP_P0; ++rep) {
        __syncthreads();
        KArgs a = KA(); unsigned char* ws = a->ws; float* MOD = (float*)(ws + WS_MOD);
        const int tid = TIDV(), lane = tid & 63, wave = __builtin_amdgcn_readfirstlane(tid >> 6), gw = blockIdx.x * 8 + wave, NGW = G * 8;
        LAS float* sv = (LAS float*)lds; LAS float* red = (LAS float*)(lds + 20480);
        for (int i = tid; i < 5 * D; i += 512) { const int mi = i >> 10, d = i & 1023; const float x = mi ? a->c[(mi - 1) * D + d] : a->cctx[d]; sv[i] = x * fsigmoid(x); }
        __syncthreads();
        for (int unit = blockIdx.x; unit < 288; unit += G) {
            const int l = unit / 144, cb = unit % 144, col = cb * 64 + lane;
            const float* wp = a->wmod + (size_t)l * D * NMODE + (size_t)(128 * wave) * NMODE + col;
            float a0 = 0.f, a1 = 0.f, a2 = 0.f, a3 = 0.f, a4 = 0.f;
#pragma unroll 8
            for (int d = 0; d < 128; ++d) { const float wv = wp[(size_t)d * NMODE]; const int dd = 128 * wave + d;
                a0 += sv[dd] * wv; a1 += sv[D + dd] * wv; a2 += sv[2 * D + dd] * wv; a3 += sv[3 * D + dd] * wv; a4 += sv[4 * D + dd] * wv; }
            red[(wave * 5 + 0) * 64 + lane] = a0; red[(wave * 5 + 1) * 64 + lane] = a1; red[(wave * 5 + 2) * 64 + lane] = a2; red[(wave * 5 + 3) * 64 + lane] = a3; red[(wave * 5 + 4) * 64 + lane] = a4;
            __syncthreads();
            if (tid < 320) { const int mi = tid >> 6, cl = tid & 63; float sacc = 0.f;
#pragma unroll
                for (int ww = 0; ww < 8; ++ww) sacc += red[(ww * 5 + mi) * 64 + cl];
                MOD[(size_t)(l * 5 + mi) * NMODE + cb * 64 + cl] = sacc + a->bmod[l * NMODE + cb * 64 + cl]; }
            __syncthreads();
        }
        LAS float* scr = (LAS float*)(lds + 32768 + wave * 8448);
        constexpr int I_FIN = 16 * 176, I_FOUT = 44 * 32, I_AIN = 16 * 96, I_SQ = 16 * 32, I_HIN = 16 * 160;
        constexpr int NITEMS = 4 * I_FIN + 4 * I_FOUT + I_AIN + I_SQ + I_HIN + I_SQ;
        for (int it = gw; it < NITEMS; it += NGW) {
            int q = it;
            if (q < 4 * I_FIN) { const int m = q / I_FIN; q -= m * I_FIN;
                bf16* dst = (bf16*)(ws + (m == 0 ? WS_FIN00 : m == 1 ? WS_FIN01 : m == 2 ? WS_FIN10 : WS_FIN11));
                transpose_item(a->ffn_in + (size_t)m * D * (2 * FH), D, 2 * FH, dst, true, scr, q, lane); continue; }
            q -= 4 * I_FIN;
            if (q < 4 * I_FOUT) { const int m = q / I_FOUT; q -= m * I_FOUT;
                bf16* dst = (bf16*)(ws + (m == 0 ? WS_FOUT00 : m == 1 ? WS_FOUT01 : m == 2 ? WS_FOUT10 : WS_FOUT11));
                transpose_item(a->ffn_out + (size_t)m * FH * D, FH, D, dst, false, scr, q, lane); continue; }
            q -= 4 * I_FOUT;
            if (q < I_AIN) { transpose_item(a->attn_in, D, 3 * D, (bf16*)(ws + WS_AIN), false, scr, q, lane); continue; }
            q -= I_AIN;
            if (q < I_SQ) { transpose_item(a->attn_out, D, D, (bf16*)(ws + WS_AOUT), false, scr, q, lane); continue; }
            q -= I_SQ;
            if (q < I_HIN) { transpose_item(a->hgrn_in, D, 5 * D, (bf16*)(ws + WS_HIN), false, scr, q, lane); continue; }
            q -= I_HIN;
            transpose_item(a->hgrn_out, D, D, (bf16*)(ws + WS_HOUT), false, scr, q, lane);
        }
    }
    grid.sync();
#define NORM(YY, HH, lpost, jpost, gpost_i, resw, lpre, jpre, gpre_i) do { KArgs a = KA(); unsigned char* ws = a->ws; float* MOD = (float*)(ws + WS_MOD); float* X = a->out; \
        const int tid = TIDV(), lane = tid & 63, wave = __builtin_amdgcn_readfirstlane(tid >> 6); \
        norm_phase(X, X + (size_t)TP * D, (YY) ? (const float*)(ws + WS_Y) : nullptr, X, (HH) ? (bf16*)(ws + WS_H) : nullptr, MOD + (size_t)(lpost) * 5 * NMODE, (jpost), a->normg + (size_t)(gpost_i) * D, (resw), \
                   MOD + (size_t)(lpre) * 5 * NMODE, (jpre), a->normg + (size_t)(gpre_i) * D, blockIdx.x * 8 + wave, G * 8, lane); } while (0)
    { KArgs a = KA(); unsigned char* ws = a->ws; float* MOD = (float*)(ws + WS_MOD);
      const int tid = TIDV(), lane = tid & 63, wave = __builtin_amdgcn_readfirstlane(tid >> 6);
      norm_phase(a->xp, a->xs, nullptr, a->out, (bf16*)(ws + WS_H), MOD, 0, a->normg, 0.f, MOD, 0, a->normg, blockIdx.x * 8 + wave, G * 8, lane); }
    GSYNC();
    for (int l = 0; l < 2; ++l) {
        for (int half = 0; half < 2; ++half) {
            {
                unsigned char* ws = KA()->ws;
                const bf16* Wt = (const bf16*)(ws + (l == 0 ? (half ? WS_FIN01 : WS_FIN00) : (half ? WS_FIN11 : WS_FIN10)));
                pg8::Gemm g{(const bf16*)(ws + WS_H), Wt, T, 2 * FH, D}; pg8::StaticOrder S; S.init(T, 2 * FH, G, (int)blockIdx.x);
                EpiSwiglu E{(bf16*)(ws + WS_ACT)};
                pg8::gemm_phase<EpiSwiglu, pg8::StaticOrder, true, true>(lds, g, S, E);
            }
            GSYNC();
            {
                unsigned char* ws = KA()->ws;
                const bf16* Wt = (const bf16*)(ws + (l == 0 ? (half ? WS_FOUT01 : WS_FOUT00) : (half ? WS_FOUT11 : WS_FOUT10)));
                pg8::Gemm g{(const bf16*)(ws + WS_ACT), Wt, T, D, FH}; pg8::StaticOrder S; S.init(T, D, G, (int)blockIdx.x);
                EpiF32 E{(float*)(ws + WS_Y)};
                pg8::gemm_phase<EpiF32, pg8::StaticOrder, true, true>(lds, g, S, E);
            }
            GSYNC();
            if (half == 0) NORM(true, true, l, 0, l * 6 + 1, 0.5f, l, 1, l * 6 + 2);
            else if (l == 0) NORM(true, true, 0, 2, 5, 0.5f, 1, 0, 6);
            else NORM(true, false, 1, 2, 11, 0.5f, 1, 0, 6);
            if (half == 1) { if (l == 0) GSYNC(); continue; }
            GSYNC();
            if (l == 0) {
                { KArgs a = KA(); unsigned char* ws = a->ws;
                  pg8::Gemm g{(const bf16*)(ws + WS_H), (const bf16*)(ws + WS_AIN), T, 3 * D, D}; pg8::StaticOrder S; S.init(T, 3 * D, G, (int)blockIdx.x);
                  EpiQKV E{(bf16*)(ws + WS_Q), (bf16*)(ws + WS_K), (bf16*)(ws + WS_V), a->out + OUT_NCK, a->out + OUT_NCV};
                  pg8::gemm_phase<EpiQKV, pg8::StaticOrder, true, true>(lds, g, S, E);
                  const int tid = TIDV();
                  bf16* Kc = (bf16*)(ws + WS_K) + (size_t)T * D; bf16* Vc = (bf16*)(ws + WS_V) + (size_t)T * D;
                  const float* ck = a->cache_k; const float* cv = a->cache_v;
                  for (int i = blockIdx.x * 512 + tid; i < 1024 * D / 4; i += G * 512) {
                      const f32x4 k4 = *(const f32x4*)(ck + 4 * (size_t)i), v4 = *(const f32x4*)(cv + 4 * (size_t)i);
                      u32x2 kw, vw; kw.x = cvtpk(k4.x, k4.y); kw.y = cvtpk(k4.z, k4.w); vw.x = cvtpk(v4.x, v4.y); vw.y = cvtpk(v4.z, v4.w);
                      *(u32x2*)(Kc + 4 * (size_t)i) = kw; *(u32x2*)(Vc + 4 * (size_t)i) = vw; }
                }
                GSYNC();
#ifndef NO_ATTN
                for (int rep = 0; rep < REP_ATTN; ++rep) { KArgs a = KA(); unsigned char* ws = a->ws;
                  attn_phase(lds, (const bf16*)(ws + WS_Q), (const bf16*)(ws + WS_K), (const bf16*)(ws + WS_V), (bf16*)(ws + WS_H), a->attn_lam, a->attn_subln); }
#endif
                GSYNC();
                { unsigned char* ws = KA()->ws;
                  pg8::Gemm g{(const bf16*)(ws + WS_H), (const bf16*)(ws + WS_AOUT), T, D, D}; pg8::StaticOrder S; S.init(T, D, G, (int)blockIdx.x);
                  EpiF32 E{(float*)(ws + WS_Y)};
                  pg8::gemm_phase<EpiF32, pg8::StaticOrder, true, true>(lds, g, S, E); }
            } else {
                { KArgs a = KA(); unsigned char* ws = a->ws;
                  pg8::Gemm g{(const bf16*)(ws + WS_H), (const bf16*)(ws + WS_HIN), T, 5 * D, D}; pg8::StaticOrder S; S.init(T, 5 * D, G, (int)blockIdx.x);
                  EpiHgrn E{(bf16*)(ws + WS_HQ), (bf16*)(ws + WS_HI), (bf16*)(ws + WS_HG), (float*)(ws + WS_LF), (float*)(ws + WS_LB), a->hgrn_lb};
                  pg8::gemm_phase<EpiHgrn, pg8::StaticOrder, true, true>(lds, g, S, E); }
                GSYNC();
#ifndef NO_SCAN
                for (int rep = 0; rep < REP_SCAN; ++rep) { KArgs a = KA(); unsigned char* ws = a->ws;
                  scan_phase(lds, (const bf16*)(ws + WS_HQ), (const bf16*)(ws + WS_HI), (const bf16*)(ws + WS_HG), (const float*)(ws + WS_LF), (const float*)(ws + WS_LB), (float*)(ws + WS_Y), (bf16*)(ws + WS_H),
                             a->state, a->out + OUT_ST, a->hgrn_gn); }
#endif
                GSYNC();
                { unsigned char* ws = KA()->ws;
                  pg8::Gemm g{(const bf16*)(ws + WS_H), (const bf16*)(ws + WS_HOUT), T, D, D}; pg8::StaticOrder S; S.init(T, D, G, (int)blockIdx.x);
                  EpiF32 E{(float*)(ws + WS_Y)};
                  pg8::gemm_phase<EpiF32, pg8::StaticOrder, true, true>(lds, g, S, E); }
            }
            GSYNC();
            NORM(true, true, l, 1, l * 6 + 3, 1.0f, l, 2, l * 6 + 4);
            GSYNC();
        }
    }
}

extern "C" void kernel_launch(void* const* d_in, const int* in_sizes, int n_in, void* d_out, int out_size, void* d_ws, size_t ws_size, hipStream_t stream) {
    static int grid = 0;
    if (!grid) {
        int dev = 0, cus = 0, per = 0;
        (void)hipGetDevice(&dev);
        (void)hipDeviceGetAttribute(&cus, hipDeviceAttributeMultiprocessorCount, dev);
        (void)hipFuncSetAttribute((const void*)fwd_kernel, hipFuncAttributeMaxDynamicSharedMemorySize, LDS_BYTES);
        (void)hipOccupancyMaxActiveBlocksPerMultiprocessor(&per, (const void*)fwd_kernel, 512, LDS_BYTES);
        if (per < 1) fprintf(stderr, "kernel_launch: occupancy query says %d blocks per CU\n", per);
        grid = cus > 0 ? cus : 256;
        if (ws_size < 280u * 1024u * 1024u) fprintf(stderr, "kernel_launch: workspace too small (%zu)\n", ws_size);
    }
    Args a{};
    a.xp = (const float*)d_in[0]; a.xs = (const float*)d_in[1]; a.cache_k = (const float*)d_in[2]; a.cache_v = (const float*)d_in[3]; a.state = (const float*)d_in[4];
    a.c = (const float*)d_in[5]; a.cctx = (const float*)d_in[6]; a.wmod = (const float*)d_in[7]; a.bmod = (const float*)d_in[8]; a.normg = (const float*)d_in[9];
    a.ffn_in = (const float*)d_in[10]; a.ffn_out = (const float*)d_in[11]; a.attn_in = (const float*)d_in[12]; a.attn_out = (const float*)d_in[13];
    a.attn_lam = (const float*)d_in[14]; a.attn_subln = (const float*)d_in[15]; a.hgrn_in = (const float*)d_in[16]; a.hgrn_out = (const float*)d_in[17];
    a.hgrn_lb = (const float*)d_in[18]; a.hgrn_gn = (const float*)d_in[19];
    a.out = (float*)d_out; a.ws = (unsigned char*)d_ws;
    (void)hipMemsetAsync(d_ws, 0, 16384, stream);
    void* args[] = {&a};
    hipError_t e = hipLaunchCooperativeKernel((void*)fwd_kernel, dim3(grid), dim3(512), args, LDS_BYTES, stream);
    if (e != hipSuccess) fprintf(stderr, "kernel_launch: cooperative launch failed: %s (grid %d)\n", hipGetErrorString(e), grid);
}
```

```cpp
#include <hip/hip_runtime.h>
#include <hip/hip_cooperative_groups.h>
#include <cstdio>
#include <cstdint>
namespace cg = cooperative_groups;
#ifndef REP_P0
#define REP_P0 1
#endif
#ifndef REP_ATTN
#define REP_ATTN 1
#endif
#ifndef REP_SCAN
#define REP_SCAN 1
#endif
#ifndef REP_SYNC
#define REP_SYNC 1
#endif
#define GSYNC() do { for (int _r = 0; _r < REP_SYNC; ++_r) xcd_barrier(xbar); } while (0)
namespace pg8 {
#define PG8_LAS __attribute__((address_space(3)))
typedef unsigned short bf16_t;
typedef short bf16x8 __attribute__((ext_vector_type(8)));
typedef float f32x4 __attribute__((ext_vector_type(4)));
typedef unsigned u32x4 __attribute__((ext_vector_type(4)));
constexpr int BM = 256, BK = 64, HALF = 128, HTB = HALF * BK * 2  , STAGE_BYTES = 8 * HTB, NXCD = 8, WGM = 8;

__host__ __device__ __forceinline__ int lds_byte(int r, int c) { const int st = (r >> 4) * 2 + (c >> 5), rr = r & 15, cc = c & 31, ob = rr * 64 + cc * 2; return st * 1024 + (ob ^ (((ob >> 9) & 1) << 5)); }
__host__ __device__ __forceinline__ void stage_rc(int b, int& R, int& C) { const int st = b / 1024, sb = b % 1024, swz = sb ^ (((sb >> 9) & 1) << 5); R = (st >> 1) * 16 + swz / 64; C = (st & 1) * 32 + (swz % 64) / 2; }
__host__ __device__ __forceinline__ int perm32(int rho) { const int n = rho >> 4, i = rho & 15; return 8 * (i >> 2) + 4 * n + (i & 3); }

struct Unit { int pm, pn; };
struct Gemm { const bf16_t* A; const bf16_t* Bt; int M, N, K; };

struct StaticOrder {
    int nM, nN, nwg, G, c;
    __host__ __device__ void init(int M, int N, int G_, int c_) { nM = M / BM; nN = N / BM; nwg = nM * nN; G = G_; c = c_; }
    __host__ __device__ bool next(int i, Unit& u) const {
        const long L = (long)i * G + c; if (L >= nwg) return false;
        int wgid = (int)L; { const int q = nwg / NXCD, r = nwg % NXCD, xcd = wgid % NXCD, off = wgid / NXCD; wgid = (xcd < r ? xcd * (q + 1) : r * (q + 1) + (xcd - r) * q) + off; }
        const int nig = WGM * nN, gid = wgid / nig, fm = gid * WGM, gsz = (nM - fm) < WGM ? (nM - fm) : WGM;
        u.pm = fm + ((wgid % nig) % gsz); u.pn = (wgid % nig) / gsz; return true;
    }
    __device__ __forceinline__ void a_ready(const Unit&) const {}
    __device__ __forceinline__ void done(const Unit&) const {}
};
template <class Epi, class Sched, bool ALIGN_EPI = false, bool SP2 = false>
__device__ __forceinline__ void gemm_phase(PG8_LAS unsigned char* lds, const Gemm g, const Sched& S, const Epi& E) {
    int tid_ = threadIdx.x; asm volatile("" : "+v"(tid_));
    const int tid = tid_, wid = __builtin_amdgcn_readfirstlane(tid >> 6), lane = tid & 63, wr = wid >> 2, wc = wid & 3, fr = lane & 15, fq = lane >> 4;
    const int K = g.K, nt = K / BK;
    unsigned voffA[2], voffB[2];
#pragma unroll
    for (int i = 0; i < 2; ++i) { int R, C; stage_rc(tid * 16 + i * 8192, R, C); const int Rb = Epi::PERM ? ((R & ~31) + perm32(R & 31)) : R;
        voffA[i] = (unsigned)(R * K + C) * 2u; voffB[i] = (unsigned)(Rb * K + C) * 2u; }
    const size_t kstep = (size_t)(BK * 2);
    const size_t hstep = (size_t)HALF * K * 2;
    const size_t tstep = 2 * hstep;
    const unsigned ldsw = (unsigned)wid * 1024u;
    const int aoff = lds_byte(wr * 64 + fr, fq * 8), boff = lds_byte(wc * 32 + fr, fq * 8);
#define PG8_SA(b, h) (((b) * 2 + (h)) * HTB)
#define PG8_SB(b, h) ((4 + (b) * 2 + (h)) * HTB)
#define PG8_STAGE(bufoff, gbase, voff) do { _Pragma("unroll") for (int _i = 0; _i < 2; ++_i) \
        __builtin_amdgcn_global_load_lds((const unsigned*)((const char*)(gbase) + (voff)[_i]), (PG8_LAS unsigned*)(lds + (bufoff) + ldsw + _i * 8192), 16, 0, 0); } while (0)
#define PG8_LDA(dst, b, h) do { _Pragma("unroll") for (int m = 0; m < 4; ++m) _Pragma("unroll") for (int k = 0; k < 2; ++k) dst[m][k] = *(const PG8_LAS bf16x8*)(lds + PG8_SA(b, h) + aoff + m * 2048 + k * 1024); } while (0)
#define PG8_LDB(dst, b, h) do { _Pragma("unroll") for (int n = 0; n < 2; ++n) _Pragma("unroll") for (int k = 0; k < 2; ++k) dst[n][k] = *(const PG8_LAS bf16x8*)(lds + PG8_SB(b, h) + boff + n * 2048 + k * 1024); } while (0)
#define PG8_MMA(ai, bj, At, Bt) do { __builtin_amdgcn_s_setprio(1); _Pragma("unroll") for (int m = 0; m < 4; ++m) _Pragma("unroll") for (int n = 0; n < 2; ++n) _Pragma("unroll") for (int k = 0; k < 2; ++k) \
        acc[ai][bj][m][n] = __builtin_amdgcn_mfma_f32_16x16x32_bf16(Bt[n][k], At[m][k], acc[ai][bj][m][n], 0, 0, 0); __builtin_amdgcn_s_setprio(0); } while (0)
#define PG8_WAIT_V(n) asm volatile("s_waitcnt vmcnt(" #n ")" ::: "memory")
#define PG8_WAIT_L(n) asm volatile("s_waitcnt lgkmcnt(" #n ")" ::: "memory")
#define PG8_BAR __builtin_amdgcn_s_barrier()
#define PG8_SCHED __builtin_amdgcn_sched_barrier(0)
    Unit cur, nxt; int ui = 0;
    if (!S.next(0, cur)) return;
    f32x4 acc[2][2][4][2];
#pragma unroll
    for (int a = 0; a < 2; ++a)
#pragma unroll
        for (int b = 0; b < 2; ++b)
#pragma unroll
            for (int m = 0; m < 4; ++m)
#pragma unroll
                for (int n = 0; n < 2; ++n) acc[a][b][m][n] = (f32x4){0.f, 0.f, 0.f, 0.f};
    bf16x8 At[4][2], B0[2][2], B1[2][2];
    const char* cA = (const char*)g.A + (size_t)cur.pm * tstep; const char* cB = (const char*)g.Bt + (size_t)cur.pn * tstep;
    S.a_ready(cur);
    if constexpr (SP2) {
        PG8_STAGE(PG8_SB(0, 0), cB, voffB); PG8_STAGE(PG8_SB(0, 1), cB + hstep, voffB); PG8_STAGE(PG8_SA(0, 0), cA, voffA); PG8_STAGE(PG8_SA(0, 1), cA + hstep, voffA);
        if (wr == 1) PG8_BAR;
        PG8_WAIT_V(2); PG8_BAR;
        PG8_STAGE(PG8_SB(1, 0), cB + kstep, voffB); PG8_STAGE(PG8_SA(1, 0), cA + kstep, voffA); PG8_STAGE(PG8_SB(1, 1), cB + hstep + kstep, voffB);
        PG8_WAIT_V(6); PG8_BAR;
    } else {
        PG8_STAGE(PG8_SB(0, 0), cB, voffB); PG8_STAGE(PG8_SA(0, 0), cA, voffA); PG8_STAGE(PG8_SB(0, 1), cB + hstep, voffB); PG8_STAGE(PG8_SA(0, 1), cA + hstep, voffA);
        if (wr == 1) PG8_BAR;
        PG8_WAIT_V(4); PG8_BAR;
        PG8_STAGE(PG8_SB(1, 0), cB + kstep, voffB); PG8_STAGE(PG8_SA(1, 0), cA + kstep, voffA); PG8_STAGE(PG8_SB(1, 1), cB + hstep + kstep, voffB);
        PG8_WAIT_V(6); PG8_BAR;
    }
    for (;;) {
        const bool has_next = S.next(ui + 1, nxt);
        const char* nA = has_next ? (const char*)g.A + (size_t)nxt.pm * tstep : cA; const char* nB = has_next ? (const char*)g.Bt + (size_t)nxt.pn * tstep : cB;
        for (int t = 0; t < nt; t += 2) {
            const bool last = (t == nt - 2);
            const char* a1 = cA + (size_t)(t + 1) * kstep;
            const char* a2 = last ? nA : cA + (size_t)(t + 2) * kstep; const char* b2 = last ? nB : cB + (size_t)(t + 2) * kstep;
            const char* a3 = a2 + kstep; const char* b3 = b2 + kstep;
            if (last && has_next) S.a_ready(nxt);
            if constexpr (SP2) {
            PG8_LDB(B0, 0, 0); PG8_LDB(B1, 0, 1); PG8_SCHED; PG8_LDA(At, 0, 0); PG8_STAGE(PG8_SA(1, 1), a1 + hstep, voffA);
            PG8_WAIT_V(8); PG8_WAIT_L(0); PG8_BAR; PG8_MMA(0, 0, At, B0); PG8_MMA(0, 1, At, B1); PG8_BAR; PG8_SCHED;
            PG8_LDA(At, 0, 1); PG8_STAGE(PG8_SB(0, 0), b2, voffB); PG8_STAGE(PG8_SB(0, 1), b2 + hstep, voffB); PG8_STAGE(PG8_SA(0, 0), a2, voffA);
            PG8_WAIT_V(8); PG8_WAIT_L(0); PG8_BAR; PG8_MMA(1, 0, At, B0); PG8_MMA(1, 1, At, B1); PG8_BAR; PG8_SCHED;
            PG8_LDB(B0, 1, 0); PG8_LDB(B1, 1, 1); PG8_SCHED; PG8_LDA(At, 1, 0); PG8_STAGE(PG8_SA(0, 1), a2 + hstep, voffA);
            PG8_WAIT_V(8); PG8_WAIT_L(0); PG8_BAR; PG8_MMA(0, 0, At, B0); PG8_MMA(0, 1, At, B1); PG8_BAR; PG8_SCHED;
            PG8_LDA(At, 1, 1); PG8_STAGE(PG8_SB(1, 0), b3, voffB); PG8_STAGE(PG8_SB(1, 1), b3 + hstep, voffB); PG8_STAGE(PG8_SA(1, 0), a3, voffA);
            PG8_WAIT_V(8); PG8_WAIT_L(0); PG8_BAR; PG8_MMA(1, 0, At, B0); PG8_MMA(1, 1, At, B1); PG8_BAR; PG8_SCHED;
            } else {
            PG8_LDB(B0, 0, 0); PG8_SCHED; PG8_LDA(At, 0, 0); PG8_STAGE(PG8_SA(1, 1), a1 + hstep, voffA);
            PG8_WAIT_L(8); PG8_BAR; PG8_WAIT_L(0); PG8_MMA(0, 0, At, B0); PG8_BAR; PG8_SCHED;
            PG8_LDB(B1, 0, 1); PG8_STAGE(PG8_SB(0, 0), b2, voffB);
            PG8_BAR; PG8_WAIT_L(0); PG8_MMA(0, 1, At, B1); PG8_BAR;
            PG8_LDA(At, 0, 1); PG8_STAGE(PG8_SA(0, 0), a2, voffA);
            PG8_BAR; PG8_WAIT_L(0); PG8_MMA(1, 0, At, B0); PG8_BAR; PG8_SCHED;
            PG8_STAGE(PG8_SB(0, 1), b2 + hstep, voffB);
            PG8_WAIT_V(6); PG8_BAR; PG8_MMA(1, 1, At, B1); PG8_BAR;
            PG8_LDB(B0, 1, 0); PG8_SCHED; PG8_LDA(At, 1, 0); PG8_STAGE(PG8_SA(0, 1), a2 + hstep, voffA);
            PG8_WAIT_L(8); PG8_BAR; PG8_WAIT_L(0); PG8_MMA(0, 0, At, B0); PG8_BAR; PG8_SCHED;
            PG8_LDB(B1, 1, 1); PG8_STAGE(PG8_SB(1, 0), b3, voffB);
            PG8_BAR; PG8_WAIT_L(0); PG8_MMA(0, 1, At, B1); PG8_BAR;
            PG8_LDA(At, 1, 1); PG8_STAGE(PG8_SA(1, 0), a3, voffA);
            PG8_BAR; PG8_WAIT_L(0); PG8_MMA(1, 0, At, B0); PG8_BAR; PG8_SCHED;
            PG8_STAGE(PG8_SB(1, 1), b3 + hstep, voffB);
            PG8_WAIT_V(6); PG8_BAR; PG8_MMA(1, 1, At, B1); PG8_BAR;
            }
        }
        if constexpr (ALIGN_EPI) { if (wr == 0) PG8_BAR; }
        if constexpr (!Epi::AFTER_DRAIN) { E(acc, cur, wr, wc, fr, fq); S.done(cur); }
        if (!has_next) break;
#pragma unroll
        for (int a = 0; a < 2; ++a)
#pragma unroll
            for (int b = 0; b < 2; ++b)
#pragma unroll
                for (int m = 0; m < 4; ++m)
#pragma unroll
                    for (int n = 0; n < 2; ++n) acc[a][b][m][n] = (f32x4){0.f, 0.f, 0.f, 0.f};
        cur = nxt; cA = nA; cB = nB; ++ui;
        if constexpr (ALIGN_EPI) { if (wr == 1) PG8_BAR; }
    }
    PG8_WAIT_V(0);
    if constexpr (!ALIGN_EPI) { if (wr == 0) PG8_BAR; }
    PG8_BAR;
    if constexpr (Epi::AFTER_DRAIN) { E.fused(acc, cur, wr, wc, fr, fq, lds, wid, lane); S.done(cur); }
#undef PG8_SA
#undef PG8_SB
#undef PG8_STAGE
#undef PG8_LDA
#undef PG8_LDB
#undef PG8_MMA
#undef PG8_WAIT_V
#undef PG8_WAIT_L
#undef PG8_BAR
#undef PG8_SCHED
}
}
#ifndef DI
#define DI __device__ __forceinline__
#endif
#define LAS __attribute__((address_space(3)))
typedef unsigned short bf16;
typedef float f32x2 __attribute__((ext_vector_type(2)));
typedef float f32x4 __attribute__((ext_vector_type(4)));
typedef float f32x16 __attribute__((ext_vector_type(16)));
typedef short bf16x8 __attribute__((ext_vector_type(8)));
typedef short s16x4 __attribute__((ext_vector_type(4)));
typedef unsigned u32x2 __attribute__((ext_vector_type(2)));
typedef unsigned u32x4 __attribute__((ext_vector_type(4)));
typedef __bf16 bf16x2_t __attribute__((ext_vector_type(2)));
DI unsigned cvtpk(float lo, float hi) { f32x2 v = {lo, hi}; bf16x2_t b = __builtin_convertvector(v, bf16x2_t); return __builtin_bit_cast(unsigned, b); }
DI float bf2f(bf16 b) { return __uint_as_float(((unsigned)b) << 16); }
DI float wave_sum(float v) {
#pragma unroll
    for (int o = 1; o < 64; o <<= 1) v += __shfl_xor(v, o);
    return v;
}
DI float fexp(float x) { return __builtin_amdgcn_exp2f(x * 1.4426950408889634f); }
DI float fsigmoid(float x) { return __builtin_amdgcn_rcpf(1.0f + fexp(-x)); }
DI f32x16 mfma32(bf16x8 a, bf16x8 b, f32x16 c) { return __builtin_amdgcn_mfma_f32_32x32x16_bf16(a, b, c, 0, 0, 0); }
DI bf16x8 pack8(const f32x16& x, int s) {
    u32x4 p;
    p[0] = cvtpk(x[8 * s + 0], x[8 * s + 1]); p[1] = cvtpk(x[8 * s + 2], x[8 * s + 3]);
    p[2] = cvtpk(x[8 * s + 4], x[8 * s + 5]); p[3] = cvtpk(x[8 * s + 6], x[8 * s + 7]);
    return __builtin_bit_cast(bf16x8, p);
}
DI bf16x8 cat4(s16x4 lo, s16x4 hi) { return __builtin_shufflevector(lo, hi, 0, 1, 2, 3, 4, 5, 6, 7); }

constexpr int D = 1024, TP = 4096, TSM = 8192, T = TP + TSM, FH = 2816, NMODE = 9 * D;
constexpr float EPS = 1e-6f;
constexpr size_t HM = 512u * 1024u;
constexpr size_t WS_MOD = 1 * HM;
constexpr size_t WS_FIN00 = 4 * HM, WS_FIN01 = 26 * HM, WS_FOUT00 = 48 * HM, WS_FOUT01 = 59 * HM, WS_AIN = 70 * HM, WS_AOUT = 82 * HM;
constexpr size_t WS_FIN10 = 86 * HM, WS_FOUT10 = 108 * HM, WS_HIN = 119 * HM, WS_FIN11 = 139 * HM, WS_FOUT11 = 161 * HM, WS_HOUT = 172 * HM;
constexpr size_t WS_H = 176 * HM;
constexpr size_t WS_Y = 224 * HM;
constexpr size_t WS_BIG = 320 * HM;
constexpr size_t WS_ACT = WS_BIG;
constexpr size_t WS_Q = WS_BIG, WS_K = WS_BIG + 48 * HM, WS_V = WS_K + 52 * HM;
constexpr size_t WS_HQ = WS_BIG, WS_HI = WS_BIG + 48 * HM, WS_HG = WS_BIG + 96 * HM, WS_LF = WS_BIG + 144 * HM, WS_LB = WS_BIG + 192 * HM;
constexpr size_t WS_SLOC = 4 * HM, WS_DSEG = 72 * HM;
struct EpiF32 {
    static constexpr bool PERM = false, AFTER_DRAIN = false;
    float* C;
    DI void operator()(const f32x4 (&acc)[2][2][4][2], const pg8::Unit& u, int wr, int wc, int fr, int fq) const {
        const int row0 = u.pm * 256 + wr * 64 + fr, col0 = u.pn * 256 + wc * 32 + 4 * fq;
#pragma unroll
        for (int ai = 0; ai < 2; ++ai)
#pragma unroll
            for (int m = 0; m < 4; ++m) { float* rowp = C + (size_t)(row0 + ai * 128 + m * 16) * D + col0;
#pragma unroll
                for (int bj = 0; bj < 2; ++bj)
#pragma unroll
                    for (int n = 0; n < 2; ++n) *(f32x4*)(rowp + bj * 128 + n * 16) = acc[ai][bj][m][n]; }
    }
};
struct EpiSwiglu {
    static constexpr bool PERM = false, AFTER_DRAIN = false;
    bf16* O;
    DI void operator()(const f32x4 (&acc)[2][2][4][2], const pg8::Unit& u, int wr, int wc, int fr, int fq) const {
        const int row0 = u.pm * 256 + wr * 64 + fr, col0 = u.pn * 128 + wc * 32 + 4 * fq;
#pragma unroll
        for (int ai = 0; ai < 2; ++ai)
#pragma unroll
            for (int m = 0; m < 4; ++m) { bf16* rowp = O + (size_t)(row0 + ai * 128 + m * 16) * FH + col0;
#pragma unroll
                for (int n = 0; n < 2; ++n) { const f32x4 a = acc[ai][0][m][n], b = acc[ai][1][m][n]; float r[4];
#pragma unroll
                    for (int j = 0; j < 4; ++j) r[j] = a[j] * fsigmoid(a[j]) * b[j];
                    u32x2 w; w.x = cvtpk(r[0], r[1]); w.y = cvtpk(r[2], r[3]); *(u32x2*)(rowp + n * 16) = w; } }
    }
};
constexpr float QSCALE = 0.125f * 1.4426950408889634f;
struct EpiQKV {
    static constexpr bool PERM = false, AFTER_DRAIN = false;
    bf16 *Qb, *Kb, *Vb; float *nck, *ncv;
    DI void operator()(const f32x4 (&acc)[2][2][4][2], const pg8::Unit& u, int wr, int wc, int fr, int fq) const {
        const int sec = u.pn >> 2; const bool sample = u.pm >= 16;
        const int row0 = u.pm * 256 + wr * 64 + fr, col0 = (u.pn & 3) * 256 + wc * 32 + 4 * fq;
        if (sec == 2) {
#pragma unroll
            for (int ai = 0; ai < 2; ++ai)
#pragma unroll
                for (int m = 0; m < 4; ++m) { const size_t off = (size_t)(row0 + ai * 128 + m * 16) * D + col0;
#pragma unroll
                    for (int bj = 0; bj < 2; ++bj)
#pragma unroll
                        for (int n = 0; n < 2; ++n) { const f32x4 v = acc[ai][bj][m][n]; u32x2 w; w.x = cvtpk(v[0], v[1]); w.y = cvtpk(v[2], v[3]);
                            *(u32x2*)(Vb + off + bj * 128 + n * 16) = w; if (!sample) *(f32x4*)(ncv + off + bj * 128 + n * 16) = v; } }
        } else {
            float inv[4];
#pragma unroll
            for (int j = 0; j < 4; ++j) inv[j] = __builtin_amdgcn_exp2f(-(float)(4 * fq + j) * (13.287712379549449f / 16.0f)) * 0.15915494309189535f;
            const int axis = wc & 1;
            bf16* dst = sec == 0 ? Qb : Kb; const float sc = sec == 0 ? QSCALE : 1.0f;
#pragma unroll
            for (int ai = 0; ai < 2; ++ai)
#pragma unroll
                for (int m = 0; m < 4; ++m) { const int row = row0 + ai * 128 + m * 16; const size_t off = (size_t)row * D + col0;
                    const int t = (row - TP) & 2047; const float pos = (float)(axis ? (t & 63) : (t >> 6));
                    float cs[4], sn[4];
#pragma unroll
                    for (int j = 0; j < 4; ++j) { const float rev = __builtin_amdgcn_fractf(pos * inv[j]); cs[j] = sample ? __builtin_amdgcn_cosf(rev) : 1.0f; sn[j] = sample ? __builtin_amdgcn_sinf(rev) : 0.0f; }
#pragma unroll
                    for (int bj = 0; bj < 2; ++bj) { const f32x4 x1 = acc[ai][bj][m][0], x2 = acc[ai][bj][m][1]; f32x4 o1, o2;
#pragma unroll
                        for (int j = 0; j < 4; ++j) { o1[j] = x1[j] * cs[j] - x2[j] * sn[j]; o2[j] = x1[j] * sn[j] + x2[j] * cs[j]; }
                        if (sec == 1 && !sample) { *(f32x4*)(nck + off + bj * 128) = o1; *(f32x4*)(nck + off + bj * 128 + 16) = o2; }
                        u32x2 w1, w2; w1.x = cvtpk(o1[0] * sc, o1[1] * sc); w1.y = cvtpk(o1[2] * sc, o1[3] * sc); w2.x = cvtpk(o2[0] * sc, o2[1] * sc); w2.y = cvtpk(o2[2] * sc, o2[3] * sc);
                        *(u32x2*)(dst + off + bj * 128) = w1; *(u32x2*)(dst + off + bj * 128 + 16) = w2; } }
        }
    }
};
struct EpiHgrn {
    static constexpr bool PERM = false, AFTER_DRAIN = false;
    bf16 *HQ, *HI, *HG, *LF, *LB; const float* hlb;
    DI void operator()(const f32x4 (&acc)[2][2][4][2], const pg8::Unit& u, int wr, int wc, int fr, int fq) const {
        const int sec = u.pn >> 2;
        const int row0 = u.pm * 256 + wr * 64 + fr, col0 = (u.pn & 3) * 256 + wc * 32 + 4 * fq;
        if (sec == 1 || sec == 2) {
            const int dir = sec - 1; bf16* L = dir ? LB : LF;
#pragma unroll
            for (int bj = 0; bj < 2; ++bj)
#pragma unroll
                for (int n = 0; n < 2; ++n) { const int col = col0 + bj * 128 + n * 16;
                    const f32x4 p0 = *(const f32x4*)(hlb + dir * 1024 + col), p1 = *(const f32x4*)(hlb + 2048 + dir * 1024 + col); float lb[4];
#pragma unroll
                    for (int j = 0; j < 4; ++j) lb[j] = __builtin_amdgcn_rcpf(1.0f + fexp(p0[j] - p1[j]));
#pragma unroll
                    for (int ai = 0; ai < 2; ++ai)
#pragma unroll
                        for (int m = 0; m < 4; ++m) { const f32x4 z = acc[ai][bj][m][n]; f32x4 o;
#pragma unroll
                            for (int j = 0; j < 4; ++j) { const float f = lb[j] + (1.0f - lb[j]) * fsigmoid(z[j]); o[j] = __builtin_amdgcn_logf(f) * 0.6931471805599453f; }
                            u32x2 wl; wl.x = cvtpk(o[0], o[1]); wl.y = cvtpk(o[2], o[3]); *(u32x2*)(L + (size_t)(row0 + ai * 128 + m * 16) * D + col) = wl; } }
        } else {
            bf16* dst = HQ + (size_t)(sec == 0 ? 0 : sec - 2) * ((size_t)T * D);
#pragma unroll
            for (int ai = 0; ai < 2; ++ai)
#pragma unroll
                for (int m = 0; m < 4; ++m) { const size_t off = (size_t)(row0 + ai * 128 + m * 16) * D + col0;
#pragma unroll
                    for (int bj = 0; bj < 2; ++bj)
#pragma unroll
                        for (int n = 0; n < 2; ++n) { const f32x4 v = acc[ai][bj][m][n]; u32x2 w; w.x = cvtpk(v[0], v[1]); w.y = cvtpk(v[2], v[3]); *(u32x2*)(dst + off + bj * 128 + n * 16) = w; } }
        }
    }
};
DI void transpose_item(const float* W, int K, int N, bf16* WT, bool swig, LAS float* scr, int item, int lane) {
    const int nblk = N / 32, kb = item / nblk, nb = item % nblk, k0 = 64 * kb, n0 = 32 * nb;
    int r0 = n0;
    if (swig) { const int bj = n0 >= FH ? 1 : 0, uu = n0 - bj * FH; r0 = 256 * (uu >> 7) + 128 * bj + (uu & 127); }
#pragma unroll 8
    for (int i = 0; i < 32; ++i) { const int kk = 2 * i + (lane >> 5); scr[kk * 33 + (lane & 31)] = W[(size_t)(k0 + kk) * N + n0 + (lane & 31)]; }
    asm volatile("s_waitcnt lgkmcnt(0)" ::: "memory");
    const int c = lane & 7;
#pragma unroll
    for (int j = 0; j < 4; ++j) { const int n = (lane >> 3) + 8 * j; const LAS float* s = scr + (8 * c) * 33 + n;
        u32x4 o; o.x = cvtpk(s[0 * 33], s[1 * 33]); o.y = cvtpk(s[2 * 33], s[3 * 33]); o.z = cvtpk(s[4 * 33], s[5 * 33]); o.w = cvtpk(s[6 * 33], s[7 * 33]);
        *(u32x4*)(WT + (size_t)(r0 + n) * K + k0 + 8 * c) = o; }
    asm volatile("s_waitcnt lgkmcnt(0)" ::: "memory");
}

DI void norm_phase(const float* xp, const float* xs, const float* Y, float* X, bf16* H,
                   const float* modpost, int jpost, const float* gpost, float resw,
                   const float* modpre, int jpre, const float* gpre, int gw, int NGW, int lane) {
    for (int row = gw; row < T; row += NGW) {
        const int mi = row < TP ? 0 : 1 + ((row - TP) >> 11);
        const float* xr = row < TP ? xp + (size_t)row * D : xs + (size_t)(row - TP) * D;
        f32x4 v[4];
#pragma unroll
        for (int j = 0; j < 4; ++j) v[j] = *(const f32x4*)(xr + 4 * lane + 256 * j);
        if (Y) {
            f32x4 y[4]; float s = 0.f;
#pragma unroll
            for (int j = 0; j < 4; ++j) { y[j] = *(const f32x4*)(Y + (size_t)row * D + 4 * lane + 256 * j); s += (y[j].x * y[j].x + y[j].y * y[j].y) + (y[j].z * y[j].z + y[j].w * y[j].w); }
            const float rstd = __builtin_amdgcn_rsqf(wave_sum(s) * (1.0f / D) + EPS) * resw;
            const float* gate = modpost + (size_t)mi * NMODE + (3 * jpost + 2) * D;
#pragma unroll
            for (int j = 0; j < 4; ++j) { const f32x4 gt = *(const f32x4*)(gate + 4 * lane + 256 * j), gg = *(const f32x4*)(gpost + 4 * lane + 256 * j);
                v[j] = v[j] + gt * (y[j] * rstd) * gg; }
        }
#pragma unroll
        for (int j = 0; j < 4; ++j) *(f32x4*)(X + (size_t)row * D + 4 * lane + 256 * j) = v[j];
        if (H) {
            float s = 0.f;
#pragma unroll
            for (int j = 0; j < 4; ++j) s += (v[j].x * v[j].x + v[j].y * v[j].y) + (v[j].z * v[j].z + v[j].w * v[j].w);
            const float rstd = __builtin_amdgcn_rsqf(wave_sum(s) * (1.0f / D) + EPS);
            const float* sh = modpre + (size_t)mi * NMODE + (3 * jpre) * D; const float* sc = sh + D;
#pragma unroll
            for (int j = 0; j < 4; ++j) { const f32x4 a = *(const f32x4*)(sh + 4 * lane + 256 * j), b = *(const f32x4*)(sc + 4 * lane + 256 * j), gg = *(const f32x4*)(gpre + 4 * lane + 256 * j);
                const f32x4 h = (v[j] * rstd * gg) * (b + 1.0f) + a;
                u32x2 w; w.x = cvtpk(h.x, h.y); w.y = cvtpk(h.z, h.w); *(u32x2*)(H + (size_t)row * D + 4 * lane + 256 * j) = w; }
        }
    }
}

constexpr int AK_STRIDE = 272, AV_STRIDE = 136, AK_BYTES = 64 * AK_STRIDE, AV_BYTES = 128 * AV_STRIDE;
DI void attn_phase(LAS unsigned char* lds, const bf16* Qb, const bf16* Kb, const bf16* Vb, bf16* OB, const float* lamp, const float* subln) {
    int tid_ = threadIdx.x; asm volatile("" : "+v"(tid_));
    const int tid = tid_, lane = tid & 63, w = __builtin_amdgcn_readfirstlane(tid >> 6), r = lane & 31, h = lane >> 5;
    const int qg = w >> 1, c = w & 1;
    float lam;
    { const float a = lamp[lane] * lamp[64 + lane], b = lamp[128 + lane] * lamp[192 + lane];
      lam = fexp(wave_sum(a)) - fexp(wave_sum(b)) + 0.2f; }
    const float OUTSC = 0.8f;
    for (int u = blockIdx.x; u < 768; u += gridDim.x) {
        int qrow0, krow0, krow1, nt, nt0, head;
        if (u < 512) { const int b = u >> 7; head = (u >> 4) & 7; const int qb = u & 15; qrow0 = TP + b * 2048 + qb * 128; krow0 = TP + b * 2048; krow1 = T + b * 256; nt0 = 32; nt = 36; }
        else { const int pu = u - 512, b = pu >> 4; head = (pu >> 1) & 7; qrow0 = b * 256 + (pu & 1) * 128; krow0 = b * 256; krow1 = 0; nt0 = 4; nt = 4; }
        const int qrow = qrow0 + 32 * qg + r;
        bf16x8 qf[4];
#pragma unroll
        for (int kk = 0; kk < 4; ++kk) qf[kk] = *(const bf16x8*)(Qb + (size_t)qrow * D + head * 128 + c * 64 + 16 * kk + 8 * h);
        f32x16 O[4];
#pragma unroll
        for (int vt = 0; vt < 4; ++vt)
#pragma unroll
            for (int i = 0; i < 16; ++i) O[vt][i] = 0.f;
        float mrun = -1e30f, lrun = 0.f;
        const int kkey = tid >> 3, kch = tid & 7, vkey = tid & 63, vch = tid >> 6;
        u32x4 kr0, kr1, vr0, vr1;
#define ATT_LOAD(tt) do { const int _t = (tt); const size_t _rowk = (size_t)(_t < nt0 ? krow0 + 64 * _t : krow1 + 64 * (_t - nt0)); \
            const bf16* _kp = Kb + (_rowk + kkey) * D + head * 128 + kch * 16; kr0 = *(const u32x4*)_kp; kr1 = *(const u32x4*)(_kp + 8); \
            const bf16* _vp = Vb + (_rowk + vkey) * D + head * 128 + vch * 16; vr0 = *(const u32x4*)_vp; vr1 = *(const u32x4*)(_vp + 8); } while (0)
#define ATT_STORE(bufi) do { LAS unsigned char* _kb = lds + (bufi) * (AK_BYTES + AV_BYTES); LAS unsigned char* _vb = _kb + AK_BYTES; \
            *(LAS u32x4*)(_kb + kkey * AK_STRIDE + kch * 32) = kr0; *(LAS u32x4*)(_kb + kkey * AK_STRIDE + kch * 32 + 16) = kr1; \
            _Pragma("unroll") for (int _e = 0; _e < 4; ++_e) { \
                *(LAS unsigned short*)(_vb + (vch * 16 + 2 * _e) * AV_STRIDE + vkey * 2) = (unsigned short)(vr0[_e] & 0xffffu); \
                *(LAS unsigned short*)(_vb + (vch * 16 + 2 * _e + 1) * AV_STRIDE + vkey * 2) = (unsigned short)(vr0[_e] >> 16); \
                *(LAS unsigned short*)(_vb + (vch * 16 + 8 + 2 * _e) * AV_STRIDE + vkey * 2) = (unsigned short)(vr1[_e] & 0xffffu); \
                *(LAS unsigned short*)(_vb + (vch * 16 + 8 + 2 * _e + 1) * AV_STRIDE + vkey * 2) = (unsigned short)(vr1[_e] >> 16); } } while (0)
        ATT_LOAD(0); ATT_STORE(0);
        __syncthreads();
        for (int t = 0; t < nt; ++t) {
            if (t + 1 < nt) ATT_LOAD(t + 1);
            const LAS unsigned char* kb = lds + (t & 1) * (AK_BYTES + AV_BYTES); const LAS unsigned char* vb = kb + AK_BYTES;
#pragma unroll
            for (int sub = 0; sub < 2; ++sub) {
                f32x16 s;
#pragma unroll
                for (int i = 0; i < 16; ++i) s[i] = 0.f;
#pragma unroll
                for (int kk = 0; kk < 4; ++kk) { const bf16x8 ka = *(const LAS bf16x8*)(kb + (32 * sub + r) * AK_STRIDE + c * 128 + kk * 32 + h * 16);
                    s = mfma32(ka, qf[kk], s); }
                float mx = s[0];
#pragma unroll
                for (int i = 1; i < 16; ++i) mx = fmaxf(mx, s[i]);
                mx = fmaxf(mx, __shfl_xor(mx, 32));
                const float mnew = fmaxf(mrun, mx), alpha = __builtin_amdgcn_exp2f(mrun - mnew);
                mrun = mnew;
                float ps = 0.f;
#pragma unroll
                for (int i = 0; i < 16; ++i) { s[i] = __builtin_amdgcn_exp2f(s[i] - mnew); ps += s[i]; }
                lrun = lrun * alpha + ps;
                if (__any(alpha != 1.0f)) {
#pragma unroll
                    for (int vt = 0; vt < 4; ++vt)
#pragma unroll
                        for (int i = 0; i < 16; ++i) O[vt][i] *= alpha;
                }
                const bf16x8 pf0 = pack8(s, 0), pf1 = pack8(s, 1);
#pragma unroll
                for (int vt = 0; vt < 4; ++vt) {
                    const LAS unsigned char* vp = vb + (32 * vt + r) * AV_STRIDE + (32 * sub + 4 * h) * 2;
                    O[vt] = mfma32(cat4(*(const LAS s16x4*)vp, *(const LAS s16x4*)(vp + 16)), pf0, O[vt]);
                    O[vt] = mfma32(cat4(*(const LAS s16x4*)(vp + 32), *(const LAS s16x4*)(vp + 48)), pf1, O[vt]);
                }
            }
            if (t + 1 < nt) ATT_STORE((t + 1) & 1);
            __syncthreads();
        }
#undef ATT_LOAD
#undef ATT_STORE
        LAS float* ex = (LAS float*)lds;
        { const float lt = lrun + __shfl_xor(lrun, 32); const float il = __builtin_amdgcn_rcpf(lt);
#pragma unroll
          for (int vt = 0; vt < 4; ++vt)
#pragma unroll
              for (int i = 0; i < 16; ++i) O[vt][i] *= il; }
        if (c == 1) {
#pragma unroll
            for (int vt = 0; vt < 4; ++vt)
#pragma unroll
                for (int i = 0; i < 16; ++i) { const int v = 32 * vt + (i & 3) + 8 * (i >> 2) + 4 * h; ex[(qg * 128 + v) * 32 + r] = O[vt][i]; }
        }
        __syncthreads();
        if (c == 0) {
            float ssq = 0.f;
#pragma unroll
            for (int vt = 0; vt < 4; ++vt)
#pragma unroll
                for (int i = 0; i < 16; ++i) { const int v = 32 * vt + (i & 3) + 8 * (i >> 2) + 4 * h; const float o = O[vt][i] - lam * ex[(qg * 128 + v) * 32 + r]; O[vt][i] = o; ssq += o * o; }
            ssq += __shfl_xor(ssq, 32);
            const float rstd = __builtin_amdgcn_rsqf(ssq * (1.0f / 128.0f) + EPS) * OUTSC;
            bf16* orow = OB + (size_t)qrow * D + head * 128;
#pragma unroll
            for (int vt = 0; vt < 4; ++vt)
#pragma unroll
                for (int g4 = 0; g4 < 4; ++g4) { const int v = 32 * vt + 8 * g4 + 4 * h; const f32x4 gn = *(const f32x4*)(subln + v);
                    u32x2 wv; wv.x = cvtpk(O[vt][4 * g4] * rstd * gn.x, O[vt][4 * g4 + 1] * rstd * gn.y); wv.y = cvtpk(O[vt][4 * g4 + 2] * rstd * gn.z, O[vt][4 * g4 + 3] * rstd * gn.w);
                    *(u32x2*)(orow + v) = wv; }
        }
        __syncthreads();
    }
}

constexpr int SQ_STRIDE = 272, ST_STRIDE = 80;
constexpr int SG_QH = 0, SG_KH = 32 * SQ_STRIDE, SG_KT = 2 * 32 * SQ_STRIDE, SG_VT = SG_KT + 128 * ST_STRIDE, SG_DL = SG_VT + 128 * ST_STRIDE, SG_SSQ = SG_DL + 512, SG_BYTES = SG_SSQ + 512;
DI void scan_phase(int ph, LAS unsigned char* lds, const bf16* HQ, const bf16* HI, const bf16* HG, const bf16* LF, const bf16* LB, float* OS, bf16* OB,
                   const float* st_in, float* st_out, const float* gnorm, float* SLOC, float* DSEG) {
    int tid_ = threadIdx.x; asm volatile("" : "+v"(tid_));
    const int tid = tid_, lane = tid & 63, w = __builtin_amdgcn_readfirstlane(tid >> 6), r = lane & 31, h = lane >> 5;
    const int g = w >> 2, ws = w & 3, tg = tid & 255, kc = tg >> 1, th = tg & 1;
    LAS unsigned char* gl = lds + g * SG_BYTES;
    const bf16* LG = g ? LB : LF;
    const int nitems = ph == 0 ? 384 : 256;
    for (int v = blockIdx.x; v < nitems; v += gridDim.x) {
        bool full, sample; int row0, head, b, seg = 0, p = 0;
        if (ph == 0 && v >= 128 && v < 256) { const int pi = v - 128; b = pi >> 3; head = pi & 7; row0 = b * 256; full = true; sample = false; }
        else { p = ph == 0 ? (v < 128 ? v : v - 128) : v; b = p >> 6; seg = (p >> 3) & 7; head = p & 7; row0 = TP + b * 2048 + seg * 256; full = (ph != 0); sample = true; }
        const size_t cbase = (size_t)row0 * D + head * 128;
        const bf16* LGb = LG + cbase; const bf16* HQb = HQ + cbase; const bf16* HIb = HI + cbase;
        f32x16 S[4];
#pragma unroll
        for (int Tt = 0; Tt < 4; ++Tt)
#pragma unroll
            for (int i = 0; i < 16; ++i) S[Tt][i] = 0.f;
        if (full && sample) {
            const float* sp = st_in + (size_t)((b * 2 + g) * 8 + head) * 16384 + 32 * ws + r;
#pragma unroll
            for (int Tt = 0; Tt < 4; ++Tt)
#pragma unroll
                for (int i = 0; i < 16; ++i) S[Tt][i] = sp[(32 * Tt + (i & 3) + 8 * (i >> 2) + 4 * h) * 128];
            const int nseg = g ? 7 - seg : seg;
            for (int q = 0; q < nseg; ++q) {
                const int jj = g ? 7 - q : q, pj = (b * 8 + jj) * 8 + head;
                const float* dp = DSEG + (size_t)(pj * 2 + g) * 128 + 4 * h; const float* lp = SLOC + (size_t)(pj * 2 + g) * 16384 + 32 * ws + r;
#pragma unroll
                for (int Tt = 0; Tt < 4; ++Tt)
#pragma unroll
                    for (int g4 = 0; g4 < 4; ++g4) { const f32x4 dl = *(const f32x4*)(dp + 32 * Tt + 8 * g4); const float* lq = lp + (size_t)(32 * Tt + 8 * g4 + 4 * h) * 128;
                        S[Tt][4 * g4] = S[Tt][4 * g4] * dl.x + lq[0]; S[Tt][4 * g4 + 1] = S[Tt][4 * g4 + 1] * dl.y + lq[128];
                        S[Tt][4 * g4 + 2] = S[Tt][4 * g4 + 2] * dl.z + lq[256]; S[Tt][4 * g4 + 3] = S[Tt][4 * g4 + 3] * dl.w + lq[384]; }
            }
        }
        float la[16]; unsigned qv2[8], iv2[8];
#define SC_TOK(cc, t) (g ? (255 - (32 * (cc) + (t))) : (32 * (cc) + (t)))
#define SC_LOAD(cc) do { _Pragma("unroll") for (int _t = 0; _t < 16; ++_t) la[_t] = bf2f(LGb[(unsigned)(SC_TOK(cc, 16 * th + _t) * D + kc)]); \
            _Pragma("unroll") for (int _t = 0; _t < 16; _t += 2) { const unsigned _o0 = (unsigned)(SC_TOK(cc, 16 * th + _t) * D + kc), _o1 = (unsigned)(SC_TOK(cc, 16 * th + _t + 1) * D + kc); \
                iv2[_t >> 1] = (unsigned)HIb[_o0] | ((unsigned)HIb[_o1] << 16); if (full) qv2[_t >> 1] = (unsigned)HQb[_o0] | ((unsigned)HQb[_o1] << 16); } } while (0)
#pragma unroll
        for (int t = 0; t < 8; ++t) qv2[t] = 0u;
        SC_LOAD(0);
        float bsum = 0.f;
        for (int s = 0; s < 8; ++s) {
            float suma = 0.f;
#pragma unroll
            for (int t = 0; t < 16; ++t) suma += la[t];
            const float sumo = __shfl_xor(suma, 1), blast = suma + sumo;
            bsum += blast;
            float bb = th ? sumo : 0.f;
            unsigned ktp[8];
#pragma unroll
            for (int tt = 0; tt < 16; tt += 2) {
                float ktv[2];
#pragma unroll
                for (int e = 0; e < 2; ++e) {
                    const float lft = la[tt + e];
                    bb += lft;
                    const float kk = 1.0f - fexp(lft);
                    ktv[e] = kk * fexp(blast - bb);
                    if (full) {
                        const float qh = __uint_as_float(e ? (qv2[tt >> 1] & 0xffff0000u) : (qv2[tt >> 1] << 16)) * fexp(fmaxf(bb, -80.0f)), kh = kk * fexp(fminf(-bb, 80.0f));
                        const int t = 16 * th + tt + e;
                        *(LAS unsigned short*)(gl + SG_QH + t * SQ_STRIDE + kc * 2) = (unsigned short)(cvtpk(qh, 0.f) & 0xffffu);
                        *(LAS unsigned short*)(gl + SG_KH + t * SQ_STRIDE + kc * 2) = (unsigned short)(cvtpk(kh, 0.f) & 0xffffu);
                    }
                }
                ktp[tt >> 1] = cvtpk(ktv[0], ktv[1]);
            }
            { u32x4 a, bq; a.x = ktp[0]; a.y = ktp[1]; a.z = ktp[2]; a.w = ktp[3]; bq.x = ktp[4]; bq.y = ktp[5]; bq.z = ktp[6]; bq.w = ktp[7];
              *(LAS u32x4*)(gl + SG_KT + kc * ST_STRIDE + th * 32) = a; *(LAS u32x4*)(gl + SG_KT + kc * ST_STRIDE + th * 32 + 16) = bq;
              a.x = iv2[0]; a.y = iv2[1]; a.z = iv2[2]; a.w = iv2[3]; bq.x = iv2[4]; bq.y = iv2[5]; bq.z = iv2[6]; bq.w = iv2[7];
              *(LAS u32x4*)(gl + SG_VT + kc * ST_STRIDE + th * 32) = a; *(LAS u32x4*)(gl + SG_VT + kc * ST_STRIDE + th * 32 + 16) = bq; }
            if (th == 0) *(LAS float*)(gl + SG_DL + kc * 4) = fexp(blast);
            __syncthreads();
            if (s + 1 < 8) SC_LOAD(s + 1);
            const size_t obase = cbase + (size_t)SC_TOK(s, r) * D + 32 * ws + 4 * h;
            const bool second = (s >= 4);
            f32x16 o;
            f32x4 pv[4]; u32x2 gv[4];
            if (full) {
                if (second) {
#pragma unroll
                    for (int g4 = 0; g4 < 4; ++g4) { pv[g4] = *(const f32x4*)(OS + obase + 8 * g4); gv[g4] = *(const u32x2*)(HG + obase + 8 * g4); }
                }
                f32x16 at, at2;
#pragma unroll
                for (int i = 0; i < 16; ++i) { at[i] = 0.f; at2[i] = 0.f; }
#pragma unroll
                for (int kk = 0; kk < 8; kk += 2) {
                    const bf16x8 ka = *(const LAS bf16x8*)(gl + SG_KH + r * SQ_STRIDE + kk * 32 + h * 16), qb = *(const LAS bf16x8*)(gl + SG_QH + r * SQ_STRIDE + kk * 32 + h * 16);
                    const bf16x8 ka2 = *(const LAS bf16x8*)(gl + SG_KH + r * SQ_STRIDE + kk * 32 + 32 + h * 16), qb2 = *(const LAS bf16x8*)(gl + SG_QH + r * SQ_STRIDE + kk * 32 + 32 + h * 16);
                    at = mfma32(ka, qb, at); at2 = mfma32(ka2, qb2, at2); }
#pragma unroll
                for (int i = 0; i < 16; ++i) { const int srow = (i & 3) + 8 * (i >> 2) + 4 * h; at[i] = srow > r ? 0.f : at[i] + at2[i]; }
#pragma unroll
                for (int i = 0; i < 16; ++i) o[i] = 0.f;
#pragma unroll
                for (int jj = 0; jj < 2; ++jj) { const LAS unsigned char* vp = gl + SG_VT + (32 * ws + r) * ST_STRIDE + (16 * jj + 4 * h) * 2;
                    o = mfma32(cat4(*(const LAS s16x4*)vp, *(const LAS s16x4*)(vp + 16)), pack8(at, jj), o); }
#pragma unroll
                for (int Tt = 0; Tt < 4; ++Tt)
#pragma unroll
                    for (int jj = 0; jj < 2; ++jj) { const LAS unsigned char* qp = gl + SG_QH + r * SQ_STRIDE + (32 * Tt + 16 * jj + 4 * h) * 2;
                        o = mfma32(pack8(S[Tt], jj), cat4(*(const LAS s16x4*)qp, *(const LAS s16x4*)(qp + 16)), o); }
            }
#pragma unroll
            for (int Tt = 0; Tt < 4; ++Tt) {
#pragma unroll
                for (int g4 = 0; g4 < 4; ++g4) { const f32x4 dl = *(const LAS f32x4*)(gl + SG_DL + (32 * Tt + 8 * g4 + 4 * h) * 4);
                    S[Tt][4 * g4] *= dl.x; S[Tt][4 * g4 + 1] *= dl.y; S[Tt][4 * g4 + 2] *= dl.z; S[Tt][4 * g4 + 3] *= dl.w; }
#pragma unroll
                for (int jj = 0; jj < 2; ++jj) { const bf16x8 ka = *(const LAS bf16x8*)(gl + SG_KT + (32 * Tt + r) * ST_STRIDE + (16 * jj + 8 * h) * 2), vbq = *(const LAS bf16x8*)(gl + SG_VT + (32 * ws + r) * ST_STRIDE + (16 * jj + 8 * h) * 2);
                    S[Tt] = mfma32(ka, vbq, S[Tt]); }
            }
            if (full) {
                if (!second) {
#pragma unroll
                    for (int g4 = 0; g4 < 4; ++g4) { f32x4 vv; vv.x = o[4 * g4]; vv.y = o[4 * g4 + 1]; vv.z = o[4 * g4 + 2]; vv.w = o[4 * g4 + 3]; *(f32x4*)(OS + obase + 8 * g4) = vv; }
                    if (s == 3) asm volatile("s_waitcnt vmcnt(0)" ::: "memory");
                } else {
                    float ssq = 0.f;
#pragma unroll
                    for (int g4 = 0; g4 < 4; ++g4) { const f32x4 pp = pv[g4];
                        o[4 * g4] += pp.x; o[4 * g4 + 1] += pp.y; o[4 * g4 + 2] += pp.z; o[4 * g4 + 3] += pp.w;
                        ssq += (o[4 * g4] * o[4 * g4] + o[4 * g4 + 1] * o[4 * g4 + 1]) + (o[4 * g4 + 2] * o[4 * g4 + 2] + o[4 * g4 + 3] * o[4 * g4 + 3]); }
                    ssq += __shfl_xor(ssq, 32);
                    if (h == 0) *(LAS float*)(gl + SG_SSQ + (r * 4 + ws) * 4) = ssq;
                    __syncthreads();
                    const f32x4 sq = *(const LAS f32x4*)(gl + SG_SSQ + r * 16);
                    const float rstd = __builtin_amdgcn_rsqf(((sq.x + sq.y) + (sq.z + sq.w)) * (1.0f / 128.0f) + EPS);
#pragma unroll
                    for (int g4 = 0; g4 < 4; ++g4) { const u32x2 gg = gv[g4]; const f32x4 gn = *(const f32x4*)(gnorm + 32 * ws + 4 * h + 8 * g4);
                        const float g0 = __uint_as_float(gg.x << 16), g1 = __uint_as_float(gg.x & 0xffff0000u), g2 = __uint_as_float(gg.y << 16), g3 = __uint_as_float(gg.y & 0xffff0000u);
                        u32x2 wv; wv.x = cvtpk(o[4 * g4] * rstd * gn.x * fsigmoid(g0), o[4 * g4 + 1] * rstd * gn.y * fsigmoid(g1));
                        wv.y = cvtpk(o[4 * g4 + 2] * rstd * gn.z * fsigmoid(g2), o[4 * g4 + 3] * rstd * gn.w * fsigmoid(g3));
                        *(u32x2*)(OB + obase + 8 * g4) = wv; }
                }
            }
            __syncthreads();
        }
#undef SC_LOAD
#undef SC_TOK
        if (!full) {
            float* sp = SLOC + (size_t)(p * 2 + g) * 16384 + 32 * ws + r;
#pragma unroll
            for (int Tt = 0; Tt < 4; ++Tt)
#pragma unroll
                for (int i = 0; i < 16; ++i) sp[(32 * Tt + (i & 3) + 8 * (i >> 2) + 4 * h) * 128] = S[Tt][i];
            if (th == 0 && ws == 0) { }
            if (th == 0) DSEG[(size_t)(p * 2 + g) * 128 + kc] = fexp(bsum);
        } else if (!sample) {
            float* sp = st_out + (size_t)((b * 2 + g) * 8 + head) * 16384 + 32 * ws + r;
#pragma unroll
            for (int Tt = 0; Tt < 4; ++Tt)
#pragma unroll
                for (int i = 0; i < 16; ++i) sp[(32 * Tt + (i & 3) + 8 * (i >> 2) + 4 * h) * 128] = S[Tt][i];
        }
    }
}

#define GAS __attribute__((address_space(1)))
#define XB_TMO      128
#define XB_XCNT(j)  (256  + 64 * (j))
#define XB_XSUB(j)  (1280 + 64 * (j))
#define XB_XGEN(j)  (2304 + 64 * (j))
#define XB_TOP      3328
#define XB_TOPGEN   3392
#define XCD_BAR_WORDS 3456
#define XB_SPIN_CAP (1u << 18)

__device__ __forceinline__ unsigned xb_ld(unsigned* p)              { return __hip_atomic_load(p, __ATOMIC_RELAXED, __HIP_MEMORY_SCOPE_AGENT); }
__device__ __forceinline__ unsigned xb_add(unsigned* p, unsigned v) { return __hip_atomic_fetch_add(p, v, __ATOMIC_RELAXED, __HIP_MEMORY_SCOPE_AGENT); }
__device__ __forceinline__ unsigned xb_xcc_id() { return (unsigned)__builtin_amdgcn_s_getreg((3 << 11) | 20) & 0xFu; }
#define XB_SPIN(cond, bar) do { unsigned _sp = 0; while (cond) { __builtin_amdgcn_s_sleep(1); \
    if ((++_sp & 255u) == 0u) { if (xb_ld(&(bar)[XB_TMO])) break; if (_sp > XB_SPIN_CAP) { atomicAdd(&(bar)[XB_TMO], 1u); break; } } } } while (0)

struct XcdBarrier {
    unsigned* bar; unsigned x;
    volatile LAS unsigned* st;
};

__device__ __forceinline__ XcdBarrier xcd_barrier_post(unsigned* bar, volatile LAS unsigned* st) {
    XcdBarrier b; b.bar = bar; b.x = xb_xcc_id(); b.st = st;
    if (threadIdx.x == 0) (void)xb_add(&bar[XB_XCNT(b.x)], 1u);
    return b;
}
__device__ __forceinline__ void xcd_barrier_complete(unsigned* bar, unsigned x, unsigned& nloc, unsigned& nx) {
    const unsigned G = gridDim.x * gridDim.y * gridDim.z;
    unsigned sum, cnt, mine, sp = 0u;
    for (;;) {
        sum = 0u; cnt = 0u; mine = 0u;
#pragma unroll
        for (unsigned j = 0; j < 16; ++j) { const unsigned c = xb_ld(&bar[XB_XCNT(j)]); sum += c; cnt += (c > 0u) ? 1u : 0u; mine = (j == x) ? c : mine; }
        if (sum == G) break;
        __builtin_amdgcn_s_sleep(1);
        if ((++sp & 255u) == 0u) { if (xb_ld(&bar[XB_TMO])) break; if (sp > XB_SPIN_CAP) { atomicAdd(&bar[XB_TMO], 1u); break; } }
    }
    nloc = mine > 0u ? mine : 1u; nx = cnt > 0u ? cnt : 1u;
}

__device__ __forceinline__ void xcd_barrier(const XcdBarrier& b) {
    asm volatile("s_waitcnt vmcnt(0)" ::: "memory");
    __syncthreads();
    if (threadIdx.x == 0) {
        unsigned* bar = b.bar;
        __builtin_amdgcn_s_waitcnt(0);
        unsigned nloc = b.st[0], nx = b.st[1];
        if (nloc == 0u) { xcd_barrier_complete(bar, b.x, nloc, nx); b.st[0] = nloc; b.st[1] = nx; }
        const unsigned old = xb_add(&bar[XB_XSUB(b.x)], 1u);
        const unsigned gen = old / nloc;
        if (old + 1u == (gen + 1u) * nloc) {
            __builtin_amdgcn_fence(__ATOMIC_RELEASE, "agent");
            asm volatile("s_waitcnt vmcnt(0)" ::: "memory");
            const unsigned og = xb_add(&bar[XB_TOP], 1u);
            const unsigned tg = og / nx;
            if (og + 1u == (tg + 1u) * nx) xb_add(&bar[XB_TOPGEN], 1u);
            else XB_SPIN(xb_ld(&bar[XB_TOPGEN]) == tg, bar);
            __builtin_amdgcn_fence(__ATOMIC_ACQUIRE, "agent");
            xb_add(&bar[XB_XGEN(b.x)], 1u);
            asm volatile("s_waitcnt vmcnt(0)" ::: "memory");
        } else {
            XB_SPIN(xb_ld(&bar[XB_XGEN(b.x)]) == gen, bar);
            __builtin_amdgcn_fence(__ATOMIC_ACQUIRE, "agent");
            asm volatile("s_waitcnt vmcnt(0)" ::: "memory");
        }
    }
    __syncthreads();
}


struct Args {
    const float *xp, *xs, *cache_k, *cache_v, *state, *c, *cctx, *wmod, *bmod, *normg, *ffn_in, *ffn_out, *attn_in, *attn_out, *attn_lam, *attn_subln, *hgrn_in, *hgrn_out, *hgrn_lb, *hgrn_gn;
    float* out; unsigned char* ws;
};
constexpr int LDS_BYTES = 147456, MISC_OFF = 131072 + 320;
constexpr size_t OUT_NCK = (size_t)T * D, OUT_NCV = OUT_NCK + (size_t)TP * D, OUT_ST = OUT_NCV + (size_t)TP * D;

typedef const __attribute__((address_space(4))) Args* KArgs;
#define KA() ({ KArgs _p = (KArgs)__builtin_amdgcn_kernarg_segment_ptr(); asm volatile("" : "+s"(_p)); _p; })
__global__ void __launch_bounds__(512) fwd_kernel(Args a_unused) {
    extern __shared__ __attribute__((aligned(16))) unsigned char lds_raw[];
    LAS unsigned char* lds = (LAS unsigned char*)lds_raw;
    cg::grid_group grid = cg::this_grid();
    const int G = gridDim.x;
    if (threadIdx.x < 64) ((volatile LAS unsigned*)(lds + MISC_OFF))[threadIdx.x] = 0u;
    __syncthreads();
    const XcdBarrier xbar = xcd_barrier_post((unsigned*)KA()->ws, (volatile LAS unsigned*)(lds + MISC_OFF) + 8);
#define TIDV() ({ int _t = threadIdx.x; asm volatile("" : "+v"(_t)); _t; })

    for (int rep = 0; rep < REP_P0; ++rep) {
        __syncthreads();
        KArgs a = KA(); unsigned char* ws = a->ws; float* MOD = (float*)(ws + WS_MOD);
        const int tid = TIDV(), lane = tid & 63, wave = __builtin_amdgcn_readfirstlane(tid >> 6), gw = blockIdx.x * 8 + wave, NGW = G * 8;
        LAS float* sv = (LAS float*)lds; LAS float* red = (LAS float*)(lds + 20480);
        for (int i = tid; i < 5 * D; i += 512) { const int mi = i >> 10, d = i & 1023; const float x = mi ? a->c[(mi - 1) * D + d] : a->cctx[d]; sv[i] = x * fsigmoid(x); }
        __syncthreads();
        for (int unit = blockIdx.x; unit < 288; unit += G) {
            const int l = unit / 144, cb = unit % 144, col = cb * 64 + lane;
            const float* wp = a->wmod + (size_t)l * D * NMODE + (size_t)(128 * wave) * NMODE + col;
            float a0 = 0.f, a1 = 0.f, a2 = 0.f, a3 = 0.f, a4 = 0.f;
#pragma unroll 8
            for (int d = 0; d < 128; ++d) { const float wv = wp[(size_t)d * NMODE]; const int dd = 128 * wave + d;
                a0 += sv[dd] * wv; a1 += sv[D + dd] * wv; a2 += sv[2 * D + dd] * wv; a3 += sv[3 * D + dd] * wv; a4 += sv[4 * D + dd] * wv; }
            red[(wave * 5 + 0) * 64 + lane] = a0; red[(wave * 5 + 1) * 64 + lane] = a1; red[(wave * 5 + 2) * 64 + lane] = a2; red[(wave * 5 + 3) * 64 + lane] = a3; red[(wave * 5 + 4) * 64 + lane] = a4;
            __syncthreads();
            if (tid < 320) { const int mi = tid >> 6, cl = tid & 63; float sacc = 0.f;
#pragma unroll
                for (int ww = 0; ww < 8; ++ww) sacc += red[(ww * 5 + mi) * 64 + cl];
                MOD[(size_t)(l * 5 + mi) * NMODE + cb * 64 + cl] = sacc + a->bmod[l * NMODE + cb * 64 + cl]; }
            __syncthreads();
        }
        LAS float* scr = (LAS float*)(lds + 32768 + wave * 8448);
        constexpr int I_FIN = 16 * 176, I_FOUT = 44 * 32, I_AIN = 16 * 96, I_SQ = 16 * 32, I_HIN = 16 * 160;
        constexpr int NITEMS = 4 * I_FIN + 4 * I_FOUT + I_AIN + I_SQ + I_HIN + I_SQ;
        for (int it = gw; it < NITEMS; it += NGW) {
            int q = it;
            if (q < 4 * I_FIN) { const int m = q / I_FIN; q -= m * I_FIN;
                bf16* dst = (bf16*)(ws + (m == 0 ? WS_FIN00 : m == 1 ? WS_FIN01 : m == 2 ? WS_FIN10 : WS_FIN11));
                transpose_item(a->ffn_in + (size_t)m * D * (2 * FH), D, 2 * FH, dst, true, scr, q, lane); continue; }
            q -= 4 * I_FIN;
            if (q < 4 * I_FOUT) { const int m = q / I_FOUT; q -= m * I_FOUT;
                bf16* dst = (bf16*)(ws + (m == 0 ? WS_FOUT00 : m == 1 ? WS_FOUT01 : m == 2 ? WS_FOUT10 : WS_FOUT11));
                transpose_item(a->ffn_out + (size_t)m * FH * D, FH, D, dst, false, scr, q, lane); continue; }
            q -= 4 * I_FOUT;
            if (q < I_AIN) { transpose_item(a->attn_in, D, 3 * D, (bf16*)(ws + WS_AIN), false, scr, q, lane); continue; }
            q -= I_AIN;
            if (q < I_SQ) { transpose_item(a->attn_out, D, D, (bf16*)(ws + WS_AOUT), false, scr, q, lane); continue; }
            q -= I_SQ;
            if (q < I_HIN) { transpose_item(a->hgrn_in, D, 5 * D, (bf16*)(ws + WS_HIN), false, scr, q, lane); continue; }
            q -= I_HIN;
            transpose_item(a->hgrn_out, D, D, (bf16*)(ws + WS_HOUT), false, scr, q, lane);
        }
    }
    grid.sync();
#define NORM(YY, HH, lpost, jpost, gpost_i, resw, lpre, jpre, gpre_i) do { KArgs a = KA(); unsigned char* ws = a->ws; float* MOD = (float*)(ws + WS_MOD); float* X = a->out; \
        const int tid = TIDV(), lane = tid & 63, wave = __builtin_amdgcn_readfirstlane(tid >> 6); \
        norm_phase(X, X + (size_t)TP * D, (YY) ? (const float*)(ws + WS_Y) : nullptr, X, (HH) ? (bf16*)(ws + WS_H) : nullptr, MOD + (size_t)(lpost) * 5 * NMODE, (jpost), a->normg + (size_t)(gpost_i) * D, (resw), \
                   MOD + (size_t)(lpre) * 5 * NMODE, (jpre), a->normg + (size_t)(gpre_i) * D, blockIdx.x * 8 + wave, G * 8, lane); } while (0)
    { KArgs a = KA(); unsigned char* ws = a->ws; float* MOD = (float*)(ws + WS_MOD);
      const int tid = TIDV(), lane = tid & 63, wave = __builtin_amdgcn_readfirstlane(tid >> 6);
      norm_phase(a->xp, a->xs, nullptr, a->out, (bf16*)(ws + WS_H), MOD, 0, a->normg, 0.f, MOD, 0, a->normg, blockIdx.x * 8 + wave, G * 8, lane); }
    GSYNC();
    for (int l = 0; l < 2; ++l) {
        for (int half = 0; half < 2; ++half) {
            {
                unsigned char* ws = KA()->ws;
                const bf16* Wt = (const bf16*)(ws + (l == 0 ? (half ? WS_FIN01 : WS_FIN00) : (half ? WS_FIN11 : WS_FIN10)));
                pg8::Gemm g{(const bf16*)(ws + WS_H), Wt, T, 2 * FH, D}; pg8::StaticOrder S; S.init(T, 2 * FH, G, (int)blockIdx.x);
                EpiSwiglu E{(bf16*)(ws + WS_ACT)};
                pg8::gemm_phase<EpiSwiglu, pg8::StaticOrder, true, true>(lds, g, S, E);
            }
            GSYNC();
            {
                unsigned char* ws = KA()->ws;
                const bf16* Wt = (const bf16*)(ws + (l == 0 ? (half ? WS_FOUT01 : WS_FOUT00) : (half ? WS_FOUT11 : WS_FOUT10)));
                pg8::Gemm g{(const bf16*)(ws + WS_ACT), Wt, T, D, FH}; pg8::StaticOrder S; S.init(T, D, G, (int)blockIdx.x);
                EpiF32 E{(float*)(ws + WS_Y)};
                pg8::gemm_phase<EpiF32, pg8::StaticOrder, true, true>(lds, g, S, E);
            }
            GSYNC();
            if (half == 0) NORM(true, true, l, 0, l * 6 + 1, 0.5f, l, 1, l * 6 + 2);
            else if (l == 0) NORM(true, true, 0, 2, 5, 0.5f, 1, 0, 6);
            else NORM(true, false, 1, 2, 11, 0.5f, 1, 0, 6);
            if (half == 1) { if (l == 0) GSYNC(); continue; }
            GSYNC();
            if (l == 0) {
                { KArgs a = KA(); unsigned char* ws = a->ws;
                  pg8::Gemm g{(const bf16*)(ws + WS_H), (const bf16*)(ws + WS_AIN), T, 3 * D, D}; pg8::StaticOrder S; S.init(T, 3 * D, G, (int)blockIdx.x);
                  EpiQKV E{(bf16*)(ws + WS_Q), (bf16*)(ws + WS_K), (bf16*)(ws + WS_V), a->out + OUT_NCK, a->out + OUT_NCV};
                  pg8::gemm_phase<EpiQKV, pg8::StaticOrder, true, true>(lds, g, S, E);
                  const int tid = TIDV();
                  bf16* Kc = (bf16*)(ws + WS_K) + (size_t)T * D; bf16* Vc = (bf16*)(ws + WS_V) + (size_t)T * D;
                  const float* ck = a->cache_k; const float* cv = a->cache_v;
                  for (int i = blockIdx.x * 512 + tid; i < 1024 * D / 4; i += G * 512) {
                      const f32x4 k4 = *(const f32x4*)(ck + 4 * (size_t)i), v4 = *(const f32x4*)(cv + 4 * (size_t)i);
                      u32x2 kw, vw; kw.x = cvtpk(k4.x, k4.y); kw.y = cvtpk(k4.z, k4.w); vw.x = cvtpk(v4.x, v4.y); vw.y = cvtpk(v4.z, v4.w);
                      *(u32x2*)(Kc + 4 * (size_t)i) = kw; *(u32x2*)(Vc + 4 * (size_t)i) = vw; }
                }
                GSYNC();
#ifndef NO_ATTN
                for (int rep = 0; rep < REP_ATTN; ++rep) { KArgs a = KA(); unsigned char* ws = a->ws;
                  attn_phase(lds, (const bf16*)(ws + WS_Q), (const bf16*)(ws + WS_K), (const bf16*)(ws + WS_V), (bf16*)(ws + WS_H), a->attn_lam, a->attn_subln); }
#endif
                GSYNC();
                { unsigned char* ws = KA()->ws;
                  pg8::Gemm g{(const bf16*)(ws + WS_H), (const bf16*)(ws + WS_AOUT), T, D, D}; pg8::StaticOrder S; S.init(T, D, G, (int)blockIdx.x);
                  EpiF32 E{(float*)(ws + WS_Y)};
                  pg8::gemm_phase<EpiF32, pg8::StaticOrder, true, true>(lds, g, S, E); }
            } else {
                { KArgs a = KA(); unsigned char* ws = a->ws;
                  pg8::Gemm g{(const bf16*)(ws + WS_H), (const bf16*)(ws + WS_HIN), T, 5 * D, D}; pg8::StaticOrder S; S.init(T, 5 * D, G, (int)blockIdx.x);
                  EpiHgrn E{(bf16*)(ws + WS_HQ), (bf16*)(ws + WS_HI), (bf16*)(ws + WS_HG), (bf16*)(ws + WS_LF), (bf16*)(ws + WS_LB), a->hgrn_lb};
                  pg8::gemm_phase<EpiHgrn, pg8::StaticOrder, true, true>(lds, g, S, E); }
                GSYNC();
#ifndef NO_SCAN
                for (int rep = 0; rep < REP_SCAN; ++rep)
                for (int ph = 0; ph < 2; ++ph) { KArgs a = KA(); unsigned char* ws = a->ws;
                  scan_phase(ph, lds, (const bf16*)(ws + WS_HQ), (const bf16*)(ws + WS_HI), (const bf16*)(ws + WS_HG), (const bf16*)(ws + WS_LF), (const bf16*)(ws + WS_LB), (float*)(ws + WS_Y), (bf16*)(ws + WS_H),
                             a->state, a->out + OUT_ST, a->hgrn_gn, (float*)(ws + WS_SLOC), (float*)(ws + WS_DSEG));
                  if (ph == 0) GSYNC(); }
#endif
                GSYNC();
                { unsigned char* ws = KA()->ws;
                  pg8::Gemm g{(const bf16*)(ws + WS_H), (const bf16*)(ws + WS_HOUT), T, D, D}; pg8::StaticOrder S; S.init(T, D, G, (int)blockIdx.x);
                  EpiF32 E{(float*)(ws + WS_Y)};
                  pg8::gemm_phase<EpiF32, pg8::StaticOrder, true, true>(lds, g, S, E); }
            }
            GSYNC();
            NORM(true, true, l, 1, l * 6 + 3, 1.0f, l, 2, l * 6 + 4);
            GSYNC();
        }
    }
}

extern "C" void kernel_launch(void* const* d_in, const int* in_sizes, int n_in, void* d_out, int out_size, void* d_ws, size_t ws_size, hipStream_t stream) {
    static int grid = 0;
    if (!grid) {
        int dev = 0, cus = 0, per = 0;
        (void)hipGetDevice(&dev);
        (void)hipDeviceGetAttribute(&cus, hipDeviceAttributeMultiprocessorCount, dev);
        (void)hipFuncSetAttribute((const void*)fwd_kernel, hipFuncAttributeMaxDynamicSharedMemorySize, LDS_BYTES);
        (void)hipOccupancyMaxActiveBlocksPerMultiprocessor(&per, (const void*)fwd_kernel, 512, LDS_BYTES);
        if (per < 1) fprintf(stderr, "kernel_launch: occupancy query says %d blocks per CU\n", per);
        grid = cus > 0 ? cus : 256;
        if (ws_size < 280u * 1024u * 1024u) fprintf(stderr, "kernel_launch: workspace too small (%zu)\n", ws_size);
    }
    Args a{};
    a.xp = (const float*)d_in[0]; a.xs = (const float*)d_in[1]; a.cache_k = (const float*)d_in[2]; a.cache_v = (const float*)d_in[3]; a.state = (const float*)d_in[4];
    a.c = (const float*)d_in[5]; a.cctx = (const float*)d_in[6]; a.wmod = (const float*)d_in[7]; a.bmod = (const float*)d_in[8]; a.normg = (const float*)d_in[9];
    a.ffn_in = (const float*)d_in[10]; a.ffn_out = (const float*)d_in[11]; a.attn_in = (const float*)d_in[12]; a.attn_out = (const float*)d_in[13];
    a.attn_lam = (const float*)d_in[14]; a.attn_subln = (const float*)d_in[15]; a.hgrn_in = (const float*)d_in[16]; a.hgrn_out = (const float*)d_in[17];
    a.hgrn_lb = (const float*)d_in[18]; a.hgrn_gn = (const float*)d_in[19];
    a.out = (float*)d_out; a.ws = (unsigned char*)d_ws;
    (void)hipMemsetAsync(d_ws, 0, 16384, stream);
    void* args[] = {&a};
    hipError_t e = hipLaunchCooperativeKernel((void*)fwd_kernel, dim3(grid), dim3(512), args, LDS_BYTES, stream);
    if (e != hipSuccess) fprintf(stderr, "kernel_launch: cooperative launch failed: %s (grid %d)\n", hipGetErrorString(e), grid);
}
```

```cpp
#include <hip/hip_runtime.h>
#include <hip/hip_cooperative_groups.h>
#include <cstdio>
#include <cstdint>
namespace cg = cooperative_groups;
#ifndef REP_P0
#define REP_P0 1
#endif
#ifndef REP_ATTN
#define REP_ATTN 1
#endif
#ifndef REP_SCAN
#define REP_SCAN 1
#endif
#ifndef REP_FIN
#define REP_FIN 1
#endif
#ifndef REP_FOUT
#define REP_FOUT 1
#endif
#ifndef REP_NORM
#define REP_NORM 1
#endif
#ifndef REP_MIXG
#define REP_MIXG 1
#endif
#ifndef PROBE_A
#define PROBE_A -1
#endif
#ifndef PROBE_B
#define PROBE_B -1
#endif
#ifndef REP_SYNC
#define REP_SYNC 1
#endif
#define STAMP() do { if (PROBE_A >= 0 && blockIdx.x == 0 && threadIdx.x == 0) { *(volatile LAS unsigned long long*)(lds + STAMP_OFF + 8 * nst) = __builtin_amdgcn_s_memrealtime(); } ++nst; } while (0)
#define GSYNC() do { for (int _r = 0; _r < REP_SYNC; ++_r) xcd_barrier(xbar); STAMP(); } while (0)
namespace pg8 {
#define PG8_LAS __attribute__((address_space(3)))
typedef unsigned short bf16_t;
typedef short bf16x8 __attribute__((ext_vector_type(8)));
typedef float f32x4 __attribute__((ext_vector_type(4)));
typedef unsigned u32x4 __attribute__((ext_vector_type(4)));
constexpr int BM = 256, BK = 64, HALF = 128, HTB = HALF * BK * 2  , STAGE_BYTES = 8 * HTB, NXCD = 8, WGM = 8;

__host__ __device__ __forceinline__ int lds_byte(int r, int c) { const int st = (r >> 4) * 2 + (c >> 5), rr = r & 15, cc = c & 31, ob = rr * 64 + cc * 2; return st * 1024 + (ob ^ (((ob >> 9) & 1) << 5)); }
__host__ __device__ __forceinline__ void stage_rc(int b, int& R, int& C) { const int st = b / 1024, sb = b % 1024, swz = sb ^ (((sb >> 9) & 1) << 5); R = (st >> 1) * 16 + swz / 64; C = (st & 1) * 32 + (swz % 64) / 2; }
__host__ __device__ __forceinline__ int perm32(int rho) { const int n = rho >> 4, i = rho & 15; return 8 * (i >> 2) + 4 * n + (i & 3); }

struct Unit { int pm, pn; };
struct Gemm { const bf16_t* A; const bf16_t* Bt; int M, N, K; };

struct StaticOrder {
    int nM, nN, nwg, G, c;
    __host__ __device__ void init(int M, int N, int G_, int c_) { nM = M / BM; nN = N / BM; nwg = nM * nN; G = G_; c = c_; }
    __host__ __device__ bool next(int i, Unit& u) const {
        const long L = (long)i * G + c; if (L >= nwg) return false;
        int wgid = (int)L; { const int q = nwg / NXCD, r = nwg % NXCD, xcd = wgid % NXCD, off = wgid / NXCD; wgid = (xcd < r ? xcd * (q + 1) : r * (q + 1) + (xcd - r) * q) + off; }
        const int nig = WGM * nN, gid = wgid / nig, fm = gid * WGM, gsz = (nM - fm) < WGM ? (nM - fm) : WGM;
        u.pm = fm + ((wgid % nig) % gsz); u.pn = (wgid % nig) / gsz; return true;
    }
    __device__ __forceinline__ void a_ready(const Unit&) const {}
    __device__ __forceinline__ void done(const Unit&) const {}
};
template <class Epi, class Sched, bool ALIGN_EPI = false, bool SP2 = false>
__device__ __forceinline__ void gemm_phase(PG8_LAS unsigned char* lds, const Gemm g, const Sched& S, const Epi& E) {
    int tid_ = threadIdx.x; asm volatile("" : "+v"(tid_));
    const int tid = tid_, wid = __builtin_amdgcn_readfirstlane(tid >> 6), lane = tid & 63, wr = wid >> 2, wc = wid & 3, fr = lane & 15, fq = lane >> 4;
    const int K = g.K, nt = K / BK;
    unsigned voffA[2], voffB[2];
#pragma unroll
    for (int i = 0; i < 2; ++i) { int R, C; stage_rc(tid * 16 + i * 8192, R, C); const int Rb = Epi::PERM ? ((R & ~31) + perm32(R & 31)) : R;
        voffA[i] = (unsigned)(R * K + C) * 2u; voffB[i] = (unsigned)(Rb * K + C) * 2u; }
    const size_t kstep = (size_t)(BK * 2);
    const size_t hstep = (size_t)HALF * K * 2;
    const size_t tstep = 2 * hstep;
    const unsigned ldsw = (unsigned)wid * 1024u;
    const int aoff = lds_byte(wr * 64 + fr, fq * 8), boff = lds_byte(wc * 32 + fr, fq * 8);
#define PG8_SA(b, h) (((b) * 2 + (h)) * HTB)
#define PG8_SB(b, h) ((4 + (b) * 2 + (h)) * HTB)
#define PG8_STAGE(bufoff, gbase, voff) do { _Pragma("unroll") for (int _i = 0; _i < 2; ++_i) \
        __builtin_amdgcn_global_load_lds((const unsigned*)((const char*)(gbase) + (voff)[_i]), (PG8_LAS unsigned*)(lds + (bufoff) + ldsw + _i * 8192), 16, 0, 0); } while (0)
#define PG8_LDA(dst, b, h) do { _Pragma("unroll") for (int m = 0; m < 4; ++m) _Pragma("unroll") for (int k = 0; k < 2; ++k) dst[m][k] = *(const PG8_LAS bf16x8*)(lds + PG8_SA(b, h) + aoff + m * 2048 + k * 1024); } while (0)
#define PG8_LDB(dst, b, h) do { _Pragma("unroll") for (int n = 0; n < 2; ++n) _Pragma("unroll") for (int k = 0; k < 2; ++k) dst[n][k] = *(const PG8_LAS bf16x8*)(lds + PG8_SB(b, h) + boff + n * 2048 + k * 1024); } while (0)
#define PG8_MMA(ai, bj, At, Bt) do { __builtin_amdgcn_s_setprio(1); _Pragma("unroll") for (int m = 0; m < 4; ++m) _Pragma("unroll") for (int n = 0; n < 2; ++n) _Pragma("unroll") for (int k = 0; k < 2; ++k) \
        acc[ai][bj][m][n] = __builtin_amdgcn_mfma_f32_16x16x32_bf16(Bt[n][k], At[m][k], acc[ai][bj][m][n], 0, 0, 0); __builtin_amdgcn_s_setprio(0); } while (0)
#define PG8_WAIT_V(n) asm volatile("s_waitcnt vmcnt(" #n ")" ::: "memory")
#define PG8_WAIT_L(n) asm volatile("s_waitcnt lgkmcnt(" #n ")" ::: "memory")
#define PG8_BAR __builtin_amdgcn_s_barrier()
#define PG8_SCHED __builtin_amdgcn_sched_barrier(0)
    Unit cur, nxt; int ui = 0;
    if (!S.next(0, cur)) return;
    f32x4 acc[2][2][4][2];
#pragma unroll
    for (int a = 0; a < 2; ++a)
#pragma unroll
        for (int b = 0; b < 2; ++b)
#pragma unroll
            for (int m = 0; m < 4; ++m)
#pragma unroll
                for (int n = 0; n < 2; ++n) acc[a][b][m][n] = (f32x4){0.f, 0.f, 0.f, 0.f};
    bf16x8 At[4][2], B0[2][2], B1[2][2];
    const char* cA = (const char*)g.A + (size_t)cur.pm * tstep; const char* cB = (const char*)g.Bt + (size_t)cur.pn * tstep;
    S.a_ready(cur);
    if constexpr (SP2) {
        PG8_STAGE(PG8_SB(0, 0), cB, voffB); PG8_STAGE(PG8_SB(0, 1), cB + hstep, voffB); PG8_STAGE(PG8_SA(0, 0), cA, voffA); PG8_STAGE(PG8_SA(0, 1), cA + hstep, voffA);
        if (wr == 1) PG8_BAR;
        PG8_WAIT_V(2); PG8_BAR;
        PG8_STAGE(PG8_SB(1, 0), cB + kstep, voffB); PG8_STAGE(PG8_SA(1, 0), cA + kstep, voffA); PG8_STAGE(PG8_SB(1, 1), cB + hstep + kstep, voffB);
        PG8_WAIT_V(6); PG8_BAR;
    } else {
        PG8_STAGE(PG8_SB(0, 0), cB, voffB); PG8_STAGE(PG8_SA(0, 0), cA, voffA); PG8_STAGE(PG8_SB(0, 1), cB + hstep, voffB); PG8_STAGE(PG8_SA(0, 1), cA + hstep, voffA);
        if (wr == 1) PG8_BAR;
        PG8_WAIT_V(4); PG8_BAR;
        PG8_STAGE(PG8_SB(1, 0), cB + kstep, voffB); PG8_STAGE(PG8_SA(1, 0), cA + kstep, voffA); PG8_STAGE(PG8_SB(1, 1), cB + hstep + kstep, voffB);
        PG8_WAIT_V(6); PG8_BAR;
    }
    for (;;) {
        const bool has_next = S.next(ui + 1, nxt);
        const char* nA = has_next ? (const char*)g.A + (size_t)nxt.pm * tstep : cA; const char* nB = has_next ? (const char*)g.Bt + (size_t)nxt.pn * tstep : cB;
        for (int t = 0; t < nt; t += 2) {
            const bool last = (t == nt - 2);
            const char* a1 = cA + (size_t)(t + 1) * kstep;
            const char* a2 = last ? nA : cA + (size_t)(t + 2) * kstep; const char* b2 = last ? nB : cB + (size_t)(t + 2) * kstep;
            const char* a3 = a2 + kstep; const char* b3 = b2 + kstep;
            if (last && has_next) S.a_ready(nxt);
            if constexpr (SP2) {
            PG8_LDB(B0, 0, 0); PG8_LDB(B1, 0, 1); PG8_SCHED; PG8_LDA(At, 0, 0); PG8_STAGE(PG8_SA(1, 1), a1 + hstep, voffA);
            PG8_WAIT_V(8); PG8_WAIT_L(0); PG8_BAR; PG8_MMA(0, 0, At, B0); PG8_MMA(0, 1, At, B1); PG8_BAR; PG8_SCHED;
            PG8_LDA(At, 0, 1); PG8_STAGE(PG8_SB(0, 0), b2, voffB); PG8_STAGE(PG8_SB(0, 1), b2 + hstep, voffB); PG8_STAGE(PG8_SA(0, 0), a2, voffA);
            PG8_WAIT_V(8); PG8_WAIT_L(0); PG8_BAR; PG8_MMA(1, 0, At, B0); PG8_MMA(1, 1, At, B1); PG8_BAR; PG8_SCHED;
            PG8_LDB(B0, 1, 0); PG8_LDB(B1, 1, 1); PG8_SCHED; PG8_LDA(At, 1, 0); PG8_STAGE(PG8_SA(0, 1), a2 + hstep, voffA);
            PG8_WAIT_V(8); PG8_WAIT_L(0); PG8_BAR; PG8_MMA(0, 0, At, B0); PG8_MMA(0, 1, At, B1); PG8_BAR; PG8_SCHED;
            PG8_LDA(At, 1, 1); PG8_STAGE(PG8_SB(1, 0), b3, voffB); PG8_STAGE(PG8_SB(1, 1), b3 + hstep, voffB); PG8_STAGE(PG8_SA(1, 0), a3, voffA);
            PG8_WAIT_V(8); PG8_WAIT_L(0); PG8_BAR; PG8_MMA(1, 0, At, B0); PG8_MMA(1, 1, At, B1); PG8_BAR; PG8_SCHED;
            } else {
            PG8_LDB(B0, 0, 0); PG8_SCHED; PG8_LDA(At, 0, 0); PG8_STAGE(PG8_SA(1, 1), a1 + hstep, voffA);
            PG8_WAIT_L(8); PG8_BAR; PG8_WAIT_L(0); PG8_MMA(0, 0, At, B0); PG8_BAR; PG8_SCHED;
            PG8_LDB(B1, 0, 1); PG8_STAGE(PG8_SB(0, 0), b2, voffB);
            PG8_BAR; PG8_WAIT_L(0); PG8_MMA(0, 1, At, B1); PG8_BAR;
            PG8_LDA(At, 0, 1); PG8_STAGE(PG8_SA(0, 0), a2, voffA);
            PG8_BAR; PG8_WAIT_L(0); PG8_MMA(1, 0, At, B0); PG8_BAR; PG8_SCHED;
            PG8_STAGE(PG8_SB(0, 1), b2 + hstep, voffB);
            PG8_WAIT_V(6); PG8_BAR; PG8_MMA(1, 1, At, B1); PG8_BAR;
            PG8_LDB(B0, 1, 0); PG8_SCHED; PG8_LDA(At, 1, 0); PG8_STAGE(PG8_SA(0, 1), a2 + hstep, voffA);
            PG8_WAIT_L(8); PG8_BAR; PG8_WAIT_L(0); PG8_MMA(0, 0, At, B0); PG8_BAR; PG8_SCHED;
            PG8_LDB(B1, 1, 1); PG8_STAGE(PG8_SB(1, 0), b3, voffB);
            PG8_BAR; PG8_WAIT_L(0); PG8_MMA(0, 1, At, B1); PG8_BAR;
            PG8_LDA(At, 1, 1); PG8_STAGE(PG8_SA(1, 0), a3, voffA);
            PG8_BAR; PG8_WAIT_L(0); PG8_MMA(1, 0, At, B0); PG8_BAR; PG8_SCHED;
            PG8_STAGE(PG8_SB(1, 1), b3 + hstep, voffB);
            PG8_WAIT_V(6); PG8_BAR; PG8_MMA(1, 1, At, B1); PG8_BAR;
            }
        }
        if constexpr (ALIGN_EPI) { if (wr == 0) PG8_BAR; }
        if constexpr (!Epi::AFTER_DRAIN) { E(acc, cur, wr, wc, fr, fq); S.done(cur); }
        if (!has_next) break;
#pragma unroll
        for (int a = 0; a < 2; ++a)
#pragma unroll
            for (int b = 0; b < 2; ++b)
#pragma unroll
                for (int m = 0; m < 4; ++m)
#pragma unroll
                    for (int n = 0; n < 2; ++n) acc[a][b][m][n] = (f32x4){0.f, 0.f, 0.f, 0.f};
        cur = nxt; cA = nA; cB = nB; ++ui;
        if constexpr (ALIGN_EPI) { if (wr == 1) PG8_BAR; }
    }
    PG8_WAIT_V(0);
    if constexpr (!ALIGN_EPI) { if (wr == 0) PG8_BAR; }
    PG8_BAR;
    if constexpr (Epi::AFTER_DRAIN) { E.fused(acc, cur, wr, wc, fr, fq, lds, wid, lane); S.done(cur); }
#undef PG8_SA
#undef PG8_SB
#undef PG8_STAGE
#undef PG8_LDA
#undef PG8_LDB
#undef PG8_MMA
#undef PG8_WAIT_V
#undef PG8_WAIT_L
#undef PG8_BAR
#undef PG8_SCHED
}
}
#ifndef DI
#define DI __device__ __forceinline__
#endif
#define LAS __attribute__((address_space(3)))
typedef unsigned short bf16;
typedef float f32x2 __attribute__((ext_vector_type(2)));
typedef float f32x4 __attribute__((ext_vector_type(4)));
typedef float f32x16 __attribute__((ext_vector_type(16)));
typedef short bf16x8 __attribute__((ext_vector_type(8)));
typedef short s16x4 __attribute__((ext_vector_type(4)));
typedef unsigned u32x2 __attribute__((ext_vector_type(2)));
typedef unsigned u32x4 __attribute__((ext_vector_type(4)));
typedef __bf16 bf16x2_t __attribute__((ext_vector_type(2)));
DI unsigned cvtpk(float lo, float hi) { f32x2 v = {lo, hi}; bf16x2_t b = __builtin_convertvector(v, bf16x2_t); return __builtin_bit_cast(unsigned, b); }
DI float bf2f(bf16 b) { return __uint_as_float(((unsigned)b) << 16); }
DI float wave_sum(float v) {
#pragma unroll
    for (int o = 1; o < 64; o <<= 1) v += __shfl_xor(v, o);
    return v;
}
DI float fexp(float x) { return __builtin_amdgcn_exp2f(x * 1.4426950408889634f); }
DI float fsigmoid(float x) { return __builtin_amdgcn_rcpf(1.0f + fexp(-x)); }
DI f32x16 mfma32(bf16x8 a, bf16x8 b, f32x16 c) { return __builtin_amdgcn_mfma_f32_32x32x16_bf16(a, b, c, 0, 0, 0); }
DI bf16x8 pack8(const f32x16& x, int s) {
    u32x4 p;
    p[0] = cvtpk(x[8 * s + 0], x[8 * s + 1]); p[1] = cvtpk(x[8 * s + 2], x[8 * s + 3]);
    p[2] = cvtpk(x[8 * s + 4], x[8 * s + 5]); p[3] = cvtpk(x[8 * s + 6], x[8 * s + 7]);
    return __builtin_bit_cast(bf16x8, p);
}
DI bf16x8 cat4(s16x4 lo, s16x4 hi) { return __builtin_shufflevector(lo, hi, 0, 1, 2, 3, 4, 5, 6, 7); }

constexpr int D = 1024, TP = 4096, TSM = 8192, T = TP + TSM, FH = 2816, NMODE = 9 * D;
constexpr float EPS = 1e-6f;
constexpr size_t HM = 512u * 1024u;
constexpr size_t WS_MOD = 1 * HM;
constexpr size_t WS_FIN00 = 4 * HM, WS_FIN01 = 26 * HM, WS_FOUT00 = 48 * HM, WS_FOUT01 = 59 * HM, WS_AIN = 70 * HM, WS_AOUT = 82 * HM;
constexpr size_t WS_FIN10 = 86 * HM, WS_FOUT10 = 108 * HM, WS_HIN = 119 * HM, WS_FIN11 = 139 * HM, WS_FOUT11 = 161 * HM, WS_HOUT = 172 * HM;
constexpr size_t WS_H = 176 * HM;
constexpr size_t WS_Y = 224 * HM;
constexpr size_t WS_BIG = 320 * HM;
constexpr size_t WS_ACT = WS_BIG;
constexpr size_t WS_Q = WS_BIG, WS_K = WS_BIG + 48 * HM, WS_V = WS_K + 52 * HM;
constexpr size_t WS_HQ = WS_BIG, WS_HI = WS_BIG + 48 * HM, WS_HG = WS_BIG + 96 * HM, WS_LF = WS_BIG + 144 * HM, WS_LB = WS_BIG + 192 * HM;
constexpr size_t WS_SLOC = 4 * HM, WS_DSEG = 72 * HM;
struct EpiF32 {
    static constexpr bool PERM = true, AFTER_DRAIN = false;
    bf16* C;
    DI void operator()(const f32x4 (&acc)[2][2][4][2], const pg8::Unit& u, int wr, int wc, int fr, int fq) const {
        const int row0 = u.pm * 256 + wr * 64 + fr, col0 = u.pn * 256 + wc * 32 + 8 * fq;
#pragma unroll
        for (int ai = 0; ai < 2; ++ai)
#pragma unroll
            for (int m = 0; m < 4; ++m) { bf16* rowp = C + (size_t)(row0 + ai * 128 + m * 16) * D + col0;
#pragma unroll
                for (int bj = 0; bj < 2; ++bj) { const f32x4 v0 = acc[ai][bj][m][0], v1 = acc[ai][bj][m][1];
                    u32x4 w; w.x = cvtpk(v0[0], v0[1]); w.y = cvtpk(v0[2], v0[3]); w.z = cvtpk(v1[0], v1[1]); w.w = cvtpk(v1[2], v1[3]); *(u32x4*)(rowp + bj * 128) = w; } }
    }
};
struct EpiSwiglu {
    static constexpr bool PERM = true, AFTER_DRAIN = false;
    bf16* O;
    DI void operator()(const f32x4 (&acc)[2][2][4][2], const pg8::Unit& u, int wr, int wc, int fr, int fq) const {
        const int row0 = u.pm * 256 + wr * 64 + fr, col0 = u.pn * 128 + wc * 32 + 8 * fq;
#pragma unroll
        for (int ai = 0; ai < 2; ++ai)
#pragma unroll
            for (int m = 0; m < 4; ++m) { bf16* rowp = O + (size_t)(row0 + ai * 128 + m * 16) * FH + col0; float rr[8];
#pragma unroll
                for (int n = 0; n < 2; ++n) { const f32x4 a = acc[ai][0][m][n], b = acc[ai][1][m][n];
#pragma unroll
                    for (int j = 0; j < 4; ++j) rr[4 * n + j] = a[j] * fsigmoid(a[j]) * b[j]; }
                u32x4 w; w.x = cvtpk(rr[0], rr[1]); w.y = cvtpk(rr[2], rr[3]); w.z = cvtpk(rr[4], rr[5]); w.w = cvtpk(rr[6], rr[7]); *(u32x4*)rowp = w; }
    }
};
constexpr float QSCALE = 0.125f * 1.4426950408889634f;
constexpr size_t VTLD = (size_t)T + 1024;
struct EpiQKV {
    static constexpr bool PERM = false, AFTER_DRAIN = false;
    bf16 *Qb, *Kb, *Vb; float *nck, *ncv;
    DI void operator()(const f32x4 (&acc)[2][2][4][2], const pg8::Unit& u, int wr, int wc, int fr, int fq) const {
        const int sec = u.pn >> 2; const bool sample = u.pm >= 16;
        const int row0 = u.pm * 256 + wr * 64 + fr, col0 = (u.pn & 3) * 256 + wc * 32 + 4 * fq;
        if (sec == 2) {
#pragma unroll
            for (int ai = 0; ai < 2; ++ai)
#pragma unroll
                for (int m = 0; m < 4; ++m) { const size_t off = (size_t)(row0 + ai * 128 + m * 16) * D + col0;
#pragma unroll
                    for (int bj = 0; bj < 2; ++bj)
#pragma unroll
                        for (int n = 0; n < 2; ++n) { const f32x4 v = acc[ai][bj][m][n]; const unsigned w0 = cvtpk(v[0], v[1]), w1 = cvtpk(v[2], v[3]);
                            bf16* vt = Vb + (size_t)(col0 + bj * 128 + n * 16) * VTLD + (row0 + ai * 128 + m * 16);
                            vt[0] = (bf16)(w0 & 0xffffu); vt[VTLD] = (bf16)(w0 >> 16); vt[2 * VTLD] = (bf16)(w1 & 0xffffu); vt[3 * VTLD] = (bf16)(w1 >> 16);
                            if (!sample) *(f32x4*)(ncv + off + bj * 128 + n * 16) = v; } }
        } else {
            float inv[4];
#pragma unroll
            for (int j = 0; j < 4; ++j) inv[j] = __builtin_amdgcn_exp2f(-(float)(4 * fq + j) * (13.287712379549449f / 16.0f)) * 0.15915494309189535f;
            const int axis = wc & 1;
            bf16* dst = sec == 0 ? Qb : Kb; const float sc = sec == 0 ? QSCALE : 1.0f;
#pragma unroll
            for (int ai = 0; ai < 2; ++ai)
#pragma unroll
                for (int m = 0; m < 4; ++m) { const int row = row0 + ai * 128 + m * 16; const size_t off = (size_t)row * D + col0;
                    const int t = (row - TP) & 2047; const float pos = (float)(axis ? (t & 63) : (t >> 6));
                    float cs[4], sn[4];
#pragma unroll
                    for (int j = 0; j < 4; ++j) { const float rev = __builtin_amdgcn_fractf(pos * inv[j]); cs[j] = sample ? __builtin_amdgcn_cosf(rev) : 1.0f; sn[j] = sample ? __builtin_amdgcn_sinf(rev) : 0.0f; }
#pragma unroll
                    for (int bj = 0; bj < 2; ++bj) { const f32x4 x1 = acc[ai][bj][m][0], x2 = acc[ai][bj][m][1]; f32x4 o1, o2;
#pragma unroll
                        for (int j = 0; j < 4; ++j) { o1[j] = x1[j] * cs[j] - x2[j] * sn[j]; o2[j] = x1[j] * sn[j] + x2[j] * cs[j]; }
                        if (sec == 1 && !sample) { *(f32x4*)(nck + off + bj * 128) = o1; *(f32x4*)(nck + off + bj * 128 + 16) = o2; }
                        u32x2 w1, w2; w1.x = cvtpk(o1[0] * sc, o1[1] * sc); w1.y = cvtpk(o1[2] * sc, o1[3] * sc); w2.x = cvtpk(o2[0] * sc, o2[1] * sc); w2.y = cvtpk(o2[2] * sc, o2[3] * sc);
                        *(u32x2*)(dst + off + bj * 128) = w1; *(u32x2*)(dst + off + bj * 128 + 16) = w2; } }
        }
    }
};
struct EpiHgrn {
    static constexpr bool PERM = true, AFTER_DRAIN = false;
    bf16 *HQ, *HI, *HG, *LF, *LB; const float* hlb;
    DI void operator()(const f32x4 (&acc)[2][2][4][2], const pg8::Unit& u, int wr, int wc, int fr, int fq) const {
        const int sec = u.pn >> 2;
        const int row0 = u.pm * 256 + wr * 64 + fr, col0 = (u.pn & 3) * 256 + wc * 32 + 8 * fq;
        if (sec == 1 || sec == 2) {
            const int dir = sec - 1; bf16* L = dir ? LB : LF;
#pragma unroll
            for (int bj = 0; bj < 2; ++bj) { const int col = col0 + bj * 128; float lb[8];
#pragma unroll
                for (int n = 0; n < 2; ++n) { const f32x4 p0 = *(const f32x4*)(hlb + dir * 1024 + col + 4 * n), p1 = *(const f32x4*)(hlb + 2048 + dir * 1024 + col + 4 * n);
#pragma unroll
                    for (int j = 0; j < 4; ++j) lb[4 * n + j] = __builtin_amdgcn_rcpf(1.0f + fexp(p0[j] - p1[j])); }
#pragma unroll
                for (int ai = 0; ai < 2; ++ai)
#pragma unroll
                    for (int m = 0; m < 4; ++m) { float o[8];
#pragma unroll
                        for (int n = 0; n < 2; ++n) { const f32x4 z = acc[ai][bj][m][n];
#pragma unroll
                            for (int j = 0; j < 4; ++j) { const float f = lb[4 * n + j] + (1.0f - lb[4 * n + j]) * fsigmoid(z[j]); o[4 * n + j] = __builtin_amdgcn_logf(f) * 0.6931471805599453f; } }
                        u32x4 wl; wl.x = cvtpk(o[0], o[1]); wl.y = cvtpk(o[2], o[3]); wl.z = cvtpk(o[4], o[5]); wl.w = cvtpk(o[6], o[7]);
                        *(u32x4*)(L + (size_t)(row0 + ai * 128 + m * 16) * D + col) = wl; } }
        } else {
            bf16* dst = HQ + (size_t)(sec == 0 ? 0 : sec - 2) * ((size_t)T * D);
#pragma unroll
            for (int ai = 0; ai < 2; ++ai)
#pragma unroll
                for (int m = 0; m < 4; ++m) { const size_t off = (size_t)(row0 + ai * 128 + m * 16) * D + col0;
#pragma unroll
                    for (int bj = 0; bj < 2; ++bj) { const f32x4 v0 = acc[ai][bj][m][0], v1 = acc[ai][bj][m][1];
                        u32x4 w; w.x = cvtpk(v0[0], v0[1]); w.y = cvtpk(v0[2], v0[3]); w.z = cvtpk(v1[0], v1[1]); w.w = cvtpk(v1[2], v1[3]); *(u32x4*)(dst + off + bj * 128) = w; } }
        }
    }
};
DI void transpose_item(const float* W, int K, int N, bf16* WT, bool swig, LAS float* scr, int item, int lane) {
    const int nblk = N / 64, kb = item / nblk, nb = item % nblk, k0 = 64 * kb, n0 = 64 * nb;
    int r0 = n0;
    if (swig) { const int bj = n0 >= FH ? 1 : 0, uu = n0 - bj * FH; r0 = 256 * (uu >> 7) + 128 * bj + (uu & 127); }
    const int lk = lane >> 4, ln = (lane & 15) * 4;
    f32x4 t[16];
#pragma unroll
    for (int i = 0; i < 16; ++i) t[i] = *(const f32x4*)(W + (size_t)(k0 + 4 * i + lk) * N + n0 + ln);
#pragma unroll
    for (int i = 0; i < 16; ++i) { LAS float* d = scr + (4 * i + lk) * 65 + ln; d[0] = t[i].x; d[1] = t[i].y; d[2] = t[i].z; d[3] = t[i].w; }
    asm volatile("s_waitcnt lgkmcnt(0)" ::: "memory");
    const int c = lane & 7;
#pragma unroll
    for (int j = 0; j < 8; ++j) { const int n = (lane >> 3) + 8 * j; const LAS float* sp = scr + (8 * c) * 65 + n;
        u32x4 o; o.x = cvtpk(sp[0 * 65], sp[1 * 65]); o.y = cvtpk(sp[2 * 65], sp[3 * 65]); o.z = cvtpk(sp[4 * 65], sp[5 * 65]); o.w = cvtpk(sp[6 * 65], sp[7 * 65]);
        *(u32x4*)(WT + (size_t)(r0 + n) * K + k0 + 8 * c) = o; }
    asm volatile("s_waitcnt lgkmcnt(0)" ::: "memory");
}

DI void norm_phase(const float* xp, const float* xs, const bf16* Y, float* X, bf16* H,
                   const float* modpost, int jpost, const float* gpost, float resw,
                   const float* modpre, int jpre, const float* gpre, int gw, int NGW, int lane) {
    const int rows_per = (T + NGW - 1) / NGW, r0 = gw * rows_per, r1 = (r0 + rows_per) < T ? (r0 + rows_per) : T;
    f32x4 v[4], vn[4], vm[4]; u32x2 yb[4], ybn[4], ybm[4]; f32x4 wv[4], av[4], bv[4]; int cur_mi = -1;
#define NP_LOAD(row_, vv, yy) do { const int _r = (row_); const float* _xr = _r < TP ? xp + (size_t)_r * D : xs + (size_t)(_r - TP) * D; \
        _Pragma("unroll") for (int _j = 0; _j < 4; ++_j) { vv[_j] = *(const f32x4*)(_xr + 4 * lane + 256 * _j); if (Y) yy[_j] = *(const u32x2*)(Y + (size_t)_r * D + 4 * lane + 256 * _j); } } while (0)
#pragma unroll
    for (int j = 0; j < 4; ++j) { yb[j] = (u32x2){0u, 0u}; ybn[j] = (u32x2){0u, 0u}; ybm[j] = (u32x2){0u, 0u}; wv[j] = (f32x4){0.f, 0.f, 0.f, 0.f}; av[j] = wv[j]; bv[j] = wv[j]; vn[j] = wv[j]; vm[j] = wv[j]; }
    if (r0 < r1) NP_LOAD(r0, v, yb);
    if (r0 + 1 < r1) NP_LOAD(r0 + 1, vn, ybn);
    for (int row = r0; row < r1; ++row) {
        const int mi = row < TP ? 0 : 1 + ((row - TP) >> 11);
        if (mi != cur_mi) {
            cur_mi = mi;
            if (Y) { const float* gate = modpost + (size_t)mi * NMODE + (3 * jpost + 2) * D;
#pragma unroll
                for (int j = 0; j < 4; ++j) wv[j] = *(const f32x4*)(gate + 4 * lane + 256 * j) * *(const f32x4*)(gpost + 4 * lane + 256 * j) * resw; }
            if (H) { const float* sh = modpre + (size_t)mi * NMODE + (3 * jpre) * D; const float* sc = sh + D;
#pragma unroll
                for (int j = 0; j < 4; ++j) { av[j] = *(const f32x4*)(sh + 4 * lane + 256 * j); bv[j] = (*(const f32x4*)(sc + 4 * lane + 256 * j) + 1.0f) * *(const f32x4*)(gpre + 4 * lane + 256 * j); } }
        }
        if (row + 2 < r1) NP_LOAD(row + 2, vm, ybm);
        if (Y) {
            f32x4 y[4]; float s = 0.f;
#pragma unroll
            for (int j = 0; j < 4; ++j) { y[j].x = __uint_as_float(yb[j].x << 16); y[j].y = __uint_as_float(yb[j].x & 0xffff0000u); y[j].z = __uint_as_float(yb[j].y << 16); y[j].w = __uint_as_float(yb[j].y & 0xffff0000u);
                s += (y[j].x * y[j].x + y[j].y * y[j].y) + (y[j].z * y[j].z + y[j].w * y[j].w); }
            const float rstd = __builtin_amdgcn_rsqf(wave_sum(s) * (1.0f / D) + EPS);
#pragma unroll
            for (int j = 0; j < 4; ++j) v[j] = v[j] + (y[j] * rstd) * wv[j];
        }
#pragma unroll
        for (int j = 0; j < 4; ++j) { if (X) *(f32x4*)(X + (size_t)row * D + 4 * lane + 256 * j) = v[j]; }
        if (H) {
            float s = 0.f;
#pragma unroll
            for (int j = 0; j < 4; ++j) s += (v[j].x * v[j].x + v[j].y * v[j].y) + (v[j].z * v[j].z + v[j].w * v[j].w);
            const float rstd = __builtin_amdgcn_rsqf(wave_sum(s) * (1.0f / D) + EPS);
#pragma unroll
            for (int j = 0; j < 4; ++j) { const f32x4 hh = (v[j] * rstd) * bv[j] + av[j];
                u32x2 w; w.x = cvtpk(hh.x, hh.y); w.y = cvtpk(hh.z, hh.w); *(u32x2*)(H + (size_t)row * D + 4 * lane + 256 * j) = w; }
        }
#pragma unroll
        for (int j = 0; j < 4; ++j) { v[j] = vn[j]; yb[j] = ybn[j]; vn[j] = vm[j]; ybn[j] = ybm[j]; }
    }
#undef NP_LOAD
}

constexpr int AK_STRIDE = 272, AV_STRIDE = 136, AK_BYTES = 64 * AK_STRIDE, AV_BYTES = 128 * AV_STRIDE;
DI void attn_phase(LAS unsigned char* lds, const bf16* Qb, const bf16* Kb, const bf16* Vb, bf16* OB, const float* lamp, const float* subln) {
    int tid_ = threadIdx.x; asm volatile("" : "+v"(tid_));
    const int tid = tid_, lane = tid & 63, w = __builtin_amdgcn_readfirstlane(tid >> 6), r = lane & 31, h = lane >> 5;
    const int qg = w >> 1, c = w & 1;
    float lam;
    { const float a = lamp[lane] * lamp[64 + lane], b = lamp[128 + lane] * lamp[192 + lane];
      lam = fexp(wave_sum(a)) - fexp(wave_sum(b)) + 0.2f; }
    const float OUTSC = 0.8f;
    const int G_ = gridDim.x, vcu = (G_ % 8 == 0) ? ((int)blockIdx.x % 8) * (G_ / 8) + (int)blockIdx.x / 8 : (int)blockIdx.x;
    for (int u = vcu; u < 768; u += G_) {
        int qrow0, krow0, krow1, nt, nt0, head;
        if (u < 512) { const int b = u >> 7; head = (u >> 4) & 7; const int qb = u & 15; qrow0 = TP + b * 2048 + qb * 128; krow0 = TP + b * 2048; krow1 = T + b * 256; nt0 = 32; nt = 36; }
        else { const int pu = u - 512, b = pu >> 4; head = (pu >> 1) & 7; qrow0 = b * 256 + (pu & 1) * 128; krow0 = b * 256; krow1 = 0; nt0 = 4; nt = 4; }
        const int qrow = qrow0 + 32 * qg + r;
        bf16x8 qf[4];
#pragma unroll
        for (int kk = 0; kk < 4; ++kk) qf[kk] = *(const bf16x8*)(Qb + (size_t)qrow * D + head * 128 + c * 64 + 16 * kk + 8 * h);
        f32x16 O[4];
#pragma unroll
        for (int vt = 0; vt < 4; ++vt)
#pragma unroll
            for (int i = 0; i < 16; ++i) O[vt][i] = 0.f;
        float mrun = 0.f, lrun = 0.f;
        const int kkey = tid >> 3, kch = tid & 7, vrow = tid >> 2, vchk = tid & 3;
        u32x4 kr0, kr1, vr0, vr1;
#define ATT_LOAD(tt) do { const int _t = (tt); const size_t _rowk = (size_t)(_t < nt0 ? krow0 + 64 * _t : krow1 + 64 * (_t - nt0)); \
            const bf16* _kp = Kb + (_rowk + kkey) * D + head * 128 + kch * 16; kr0 = *(const u32x4*)_kp; kr1 = *(const u32x4*)(_kp + 8); \
            const bf16* _vp = Vb + (size_t)(head * 128 + vrow) * VTLD + _rowk + vchk * 16; vr0 = *(const u32x4*)_vp; vr1 = *(const u32x4*)(_vp + 8); } while (0)
#define ATT_STORE(bufi) do { LAS unsigned char* _kb = lds + (bufi) * (AK_BYTES + AV_BYTES); LAS unsigned char* _vb = _kb + AK_BYTES; \
            *(LAS u32x4*)(_kb + kkey * AK_STRIDE + kch * 32) = kr0; *(LAS u32x4*)(_kb + kkey * AK_STRIDE + kch * 32 + 16) = kr1; \
            { LAS unsigned char* _vd = _vb + vrow * AV_STRIDE + vchk * 32; u32x2 _w; \
              _w.x = vr0.x; _w.y = vr0.y; *(LAS u32x2*)_vd = _w; _w.x = vr0.z; _w.y = vr0.w; *(LAS u32x2*)(_vd + 8) = _w; \
              _w.x = vr1.x; _w.y = vr1.y; *(LAS u32x2*)(_vd + 16) = _w; _w.x = vr1.z; _w.y = vr1.w; *(LAS u32x2*)(_vd + 24) = _w; } } while (0)
        ATT_LOAD(0); ATT_STORE(0);
        __syncthreads();
        for (int t = 0; t < nt; ++t) {
            if (t + 1 < nt) ATT_LOAD(t + 1);
            const LAS unsigned char* kb = lds + (t & 1) * (AK_BYTES + AV_BYTES); const LAS unsigned char* vb = kb + AK_BYTES;
            {
                bf16x8 ka[4];
#pragma unroll
                for (int kk = 0; kk < 4; ++kk) ka[kk] = *(const LAS bf16x8*)(kb + r * AK_STRIDE + c * 128 + kk * 32 + h * 16);
#pragma unroll
                for (int sub = 0; sub < 2; ++sub) {
                    f32x16 s;
#pragma unroll
                    for (int i = 0; i < 16; ++i) s[i] = -mrun;
#pragma unroll
                    for (int kk = 0; kk < 4; ++kk) s = mfma32(ka[kk], qf[kk], s);
                    s16x4 vlo[8], vhi[8];
#pragma unroll
                    for (int vt = 0; vt < 4; ++vt) { const LAS unsigned char* vp = vb + (32 * vt + r) * AV_STRIDE + (32 * sub + 4 * h) * 2;
                        vlo[2 * vt] = *(const LAS s16x4*)vp; vhi[2 * vt] = *(const LAS s16x4*)(vp + 16); vlo[2 * vt + 1] = *(const LAS s16x4*)(vp + 32); vhi[2 * vt + 1] = *(const LAS s16x4*)(vp + 48); }
                    if (sub == 0) {
#pragma unroll
                        for (int kk = 0; kk < 4; ++kk) ka[kk] = *(const LAS bf16x8*)(kb + (32 + r) * AK_STRIDE + c * 128 + kk * 32 + h * 16);
                    }
                    __builtin_amdgcn_sched_barrier(0);
                    float mx = fmaxf(fmaxf(s[0], s[1]), s[2]);
#pragma unroll
                    for (int i = 3; i < 15; i += 2) mx = fmaxf(fmaxf(mx, s[i]), s[i + 1]);
                    mx = fmaxf(mx, s[15]);
                    const bool first = (t == 0 && sub == 0);
                    if (__any(mx > 8.0f) || first) {
                        const float mf = fmaxf(mx, __shfl_xor(mx, 32));
                        const float delta = first ? mf : fmaxf(mf, 0.f);
                        const float alpha = first ? 1.0f : __builtin_amdgcn_exp2f(-delta);
                        mrun += delta; lrun *= alpha;
#pragma unroll
                        for (int i = 0; i < 16; ++i) s[i] -= delta;
#pragma unroll
                        for (int vt = 0; vt < 4; ++vt)
#pragma unroll
                            for (int i = 0; i < 16; ++i) O[vt][i] *= alpha;
                    }
                    float ps0 = 0.f, ps1 = 0.f, ps2 = 0.f, ps3 = 0.f;
#pragma unroll
                    for (int i = 0; i < 16; i += 4) { s[i] = __builtin_amdgcn_exp2f(s[i]); s[i + 1] = __builtin_amdgcn_exp2f(s[i + 1]); s[i + 2] = __builtin_amdgcn_exp2f(s[i + 2]); s[i + 3] = __builtin_amdgcn_exp2f(s[i + 3]);
                        ps0 += s[i]; ps1 += s[i + 1]; ps2 += s[i + 2]; ps3 += s[i + 3]; }
                    lrun += (ps0 + ps1) + (ps2 + ps3);
                    const bf16x8 pf0 = pack8(s, 0), pf1 = pack8(s, 1);
#pragma unroll
                    for (int vt = 0; vt < 4; ++vt) {
                        O[vt] = mfma32(cat4(vlo[2 * vt], vhi[2 * vt]), pf0, O[vt]);
                        O[vt] = mfma32(cat4(vlo[2 * vt + 1], vhi[2 * vt + 1]), pf1, O[vt]);
                    }
                }
            }
            if (t + 1 < nt) ATT_STORE((t + 1) & 1);
            __syncthreads();
        }
#undef ATT_LOAD
#undef ATT_STORE
        LAS float* ex = (LAS float*)lds;
        { const float lt = lrun + __shfl_xor(lrun, 32); const float il = __builtin_amdgcn_rcpf(lt);
#pragma unroll
          for (int vt = 0; vt < 4; ++vt)
#pragma unroll
              for (int i = 0; i < 16; ++i) O[vt][i] *= il; }
        if (c == 1) {
#pragma unroll
            for (int vt = 0; vt < 4; ++vt)
#pragma unroll
                for (int i = 0; i < 16; ++i) { const int v = 32 * vt + (i & 3) + 8 * (i >> 2) + 4 * h; ex[(qg * 128 + v) * 32 + r] = O[vt][i]; }
        }
        __syncthreads();
        if (c == 0) {
            float ssq = 0.f;
#pragma unroll
            for (int vt = 0; vt < 4; ++vt)
#pragma unroll
                for (int i = 0; i < 16; ++i) { const int v = 32 * vt + (i & 3) + 8 * (i >> 2) + 4 * h; const float o = O[vt][i] - lam * ex[(qg * 128 + v) * 32 + r]; O[vt][i] = o; ssq += o * o; }
            ssq += __shfl_xor(ssq, 32);
            const float rstd = __builtin_amdgcn_rsqf(ssq * (1.0f / 128.0f) + EPS) * OUTSC;
            bf16* orow = OB + (size_t)qrow * D + head * 128;
#pragma unroll
            for (int vt = 0; vt < 4; ++vt)
#pragma unroll
                for (int g4 = 0; g4 < 4; ++g4) { const int v = 32 * vt + 8 * g4 + 4 * h; const f32x4 gn = *(const f32x4*)(subln + v);
                    u32x2 wv; wv.x = cvtpk(O[vt][4 * g4] * rstd * gn.x, O[vt][4 * g4 + 1] * rstd * gn.y); wv.y = cvtpk(O[vt][4 * g4 + 2] * rstd * gn.z, O[vt][4 * g4 + 3] * rstd * gn.w);
                    *(u32x2*)(orow + v) = wv; }
        }
        __syncthreads();
    }
}

constexpr int SQ_STRIDE = 272, ST_STRIDE = 80;
constexpr int SRAW_OFF = 77824, SRAW_BYTES = 24576;
constexpr int SG_QH = 0, SG_KH = 32 * SQ_STRIDE, SG_KT = 2 * 32 * SQ_STRIDE, SG_VT = SG_KT + 128 * ST_STRIDE, SG_DL = SG_VT + 128 * ST_STRIDE, SG_SSQ = SG_DL + 512, SG_BYTES = SG_SSQ + 512;
DI void scan_phase(int ph, LAS unsigned char* lds, const bf16* HQ, const bf16* HI, const bf16* HG, const bf16* LF, const bf16* LB, float* OS, bf16* OB,
                   const float* st_in, float* st_out, const float* gnorm, float* SLOC, float* DSEG) {
    int tid_ = threadIdx.x; asm volatile("" : "+v"(tid_));
    const int tid = tid_, lane = tid & 63, w = __builtin_amdgcn_readfirstlane(tid >> 6), r = lane & 31, h = lane >> 5;
    const int g = w >> 2, ws = w & 3, tg = tid & 255, kc = tg >> 1, th = tg & 1;
    LAS unsigned char* gl = lds + g * SG_BYTES;
    const bf16* LG = g ? LB : LF;
    const int nitems = ph == 0 ? 384 : 256;
    for (int v = blockIdx.x; v < nitems; v += gridDim.x) {
        bool full, sample; int row0, head, b, seg = 0, p = 0;
        if (ph == 0 && v >= 128 && v < 256) { const int pi = v - 128; b = pi >> 3; head = pi & 7; row0 = b * 256; full = true; sample = false; }
        else { p = ph == 0 ? (v < 128 ? v : v - 128) : v; b = p >> 6; seg = (p >> 3) & 7; head = p & 7; row0 = TP + b * 2048 + seg * 256; full = (ph != 0); sample = true; }
        const size_t cbase = (size_t)row0 * D + head * 128;
        const bf16* LGb = LG + cbase; const bf16* HQb = HQ + cbase; const bf16* HIb = HI + cbase;
        f32x16 S[4];
#pragma unroll
        for (int Tt = 0; Tt < 4; ++Tt)
#pragma unroll
            for (int i = 0; i < 16; ++i) S[Tt][i] = 0.f;
        if (full && sample) {
            const float* sp = st_in + (size_t)((b * 2 + g) * 8 + head) * 16384 + 32 * ws + r;
#pragma unroll
            for (int Tt = 0; Tt < 4; ++Tt)
#pragma unroll
                for (int i = 0; i < 16; ++i) S[Tt][i] = sp[(32 * Tt + (i & 3) + 8 * (i >> 2) + 4 * h) * 128];
            const int nseg = g ? 7 - seg : seg;
            for (int q = 0; q < nseg; ++q) {
                const int jj = g ? 7 - q : q, pj = (b * 8 + jj) * 8 + head;
                const float* dp = DSEG + (size_t)(pj * 2 + g) * 128 + 4 * h; const float* lp = SLOC + (size_t)(pj * 2 + g) * 16384 + 32 * ws + r;
#pragma unroll
                for (int Tt = 0; Tt < 4; ++Tt)
#pragma unroll
                    for (int g4 = 0; g4 < 4; ++g4) { const f32x4 dl = *(const f32x4*)(dp + 32 * Tt + 8 * g4); const float* lq = lp + (size_t)(32 * Tt + 8 * g4 + 4 * h) * 128;
                        S[Tt][4 * g4] = S[Tt][4 * g4] * dl.x + lq[0]; S[Tt][4 * g4 + 1] = S[Tt][4 * g4 + 1] * dl.y + lq[128];
                        S[Tt][4 * g4 + 2] = S[Tt][4 * g4 + 2] * dl.z + lq[256]; S[Tt][4 * g4 + 3] = S[Tt][4 * g4 + 3] * dl.w + lq[384]; }
            }
        }
        LAS unsigned char* raw = lds + SRAW_OFF + g * SRAW_BYTES;
        u32x4 rg[6];
#define SC_TOK(cc, t) (g ? (255 - (32 * (cc) + (t))) : (32 * (cc) + (t)))
#define SC_GLOAD(cc) do { _Pragma("unroll") for (int _i = 0; _i < 2; ++_i) { const int _id = tg + 256 * _i; const unsigned _o = (unsigned)(SC_TOK(cc, _id >> 4) * D + (_id & 15) * 8); \
            rg[_i] = *(const u32x4*)(LGb + _o); rg[2 + _i] = *(const u32x4*)(HIb + _o); if (full) rg[4 + _i] = *(const u32x4*)(HQb + _o); } } while (0)
#define SC_LSTORE() do { _Pragma("unroll") for (int _i = 0; _i < 2; ++_i) { const int _id = tg + 256 * _i; \
            *(LAS u32x4*)(raw + _id * 16) = rg[_i]; *(LAS u32x4*)(raw + 8192 + _id * 16) = rg[2 + _i]; if (full) *(LAS u32x4*)(raw + 16384 + _id * 16) = rg[4 + _i]; } } while (0)
#pragma unroll
        for (int t = 0; t < 6; ++t) rg[t] = (u32x4){0u, 0u, 0u, 0u};
        SC_GLOAD(0); SC_LSTORE();
        __syncthreads();
        float bsum = 0.f;
        for (int s = 0; s < 8; ++s) {
            float la[16]; float suma = 0.f;
#pragma unroll
            for (int t = 0; t < 16; ++t) { la[t] = bf2f(*(const LAS unsigned short*)(raw + (16 * th + t) * 256 + kc * 2)); suma += la[t]; }
            const float sumo = __shfl_xor(suma, 1), blast = suma + sumo;
            bsum += blast;
            float bb = th ? sumo : 0.f;
            unsigned ktp[8];
#pragma unroll
            for (int tt = 0; tt < 16; tt += 2) {
                float ktv[2];
#pragma unroll
                for (int e = 0; e < 2; ++e) {
                    const float lft = la[tt + e];
                    bb += lft;
                    const float kk = 1.0f - fexp(lft);
                    ktv[e] = kk * fexp(blast - bb);
                    if (full) {
                        const float qh = bf2f(*(const LAS unsigned short*)(raw + 16384 + (16 * th + tt + e) * 256 + kc * 2)) * fexp(fmaxf(bb, -80.0f)), kh = kk * fexp(fminf(-bb, 80.0f));
                        const int t = 16 * th + tt + e;
                        *(LAS unsigned short*)(gl + SG_QH + t * SQ_STRIDE + kc * 2) = (unsigned short)(cvtpk(qh, 0.f) & 0xffffu);
                        *(LAS unsigned short*)(gl + SG_KH + t * SQ_STRIDE + kc * 2) = (unsigned short)(cvtpk(kh, 0.f) & 0xffffu);
                    }
                }
                ktp[tt >> 1] = cvtpk(ktv[0], ktv[1]);
            }
            { u32x4 a, bq; a.x = ktp[0]; a.y = ktp[1]; a.z = ktp[2]; a.w = ktp[3]; bq.x = ktp[4]; bq.y = ktp[5]; bq.z = ktp[6]; bq.w = ktp[7];
              *(LAS u32x4*)(gl + SG_KT + kc * ST_STRIDE + th * 32) = a; *(LAS u32x4*)(gl + SG_KT + kc * ST_STRIDE + th * 32 + 16) = bq;
              unsigned iv2[8];
#pragma unroll
              for (int q = 0; q < 8; ++q) iv2[q] = (unsigned)*(const LAS unsigned short*)(raw + 8192 + (16 * th + 2 * q) * 256 + kc * 2) | ((unsigned)*(const LAS unsigned short*)(raw + 8192 + (16 * th + 2 * q + 1) * 256 + kc * 2) << 16);
              a.x = iv2[0]; a.y = iv2[1]; a.z = iv2[2]; a.w = iv2[3]; bq.x = iv2[4]; bq.y = iv2[5]; bq.z = iv2[6]; bq.w = iv2[7];
              *(LAS u32x4*)(gl + SG_VT + kc * ST_STRIDE + th * 32) = a; *(LAS u32x4*)(gl + SG_VT + kc * ST_STRIDE + th * 32 + 16) = bq; }
            if (th == 0) *(LAS float*)(gl + SG_DL + kc * 4) = fexp(blast);
            __syncthreads();
            if (s + 1 < 8) SC_GLOAD(s + 1);
            const size_t obase = cbase + (size_t)SC_TOK(s, r) * D + 32 * ws + 4 * h;
            const bool second = (s >= 4);
            f32x16 o;
            f32x4 pv[4]; u32x2 gv[4];
            if (full) {
                if (second) {
#pragma unroll
                    for (int g4 = 0; g4 < 4; ++g4) { pv[g4] = *(const f32x4*)(OS + obase + 8 * g4); gv[g4] = *(const u32x2*)(HG + obase + 8 * g4); }
                }
                f32x16 at, at2;
#pragma unroll
                for (int i = 0; i < 16; ++i) { at[i] = 0.f; at2[i] = 0.f; }
#pragma unroll
                for (int kk = 0; kk < 8; kk += 2) {
                    const bf16x8 ka = *(const LAS bf16x8*)(gl + SG_KH + r * SQ_STRIDE + kk * 32 + h * 16), qb = *(const LAS bf16x8*)(gl + SG_QH + r * SQ_STRIDE + kk * 32 + h * 16);
                    const bf16x8 ka2 = *(const LAS bf16x8*)(gl + SG_KH + r * SQ_STRIDE + kk * 32 + 32 + h * 16), qb2 = *(const LAS bf16x8*)(gl + SG_QH + r * SQ_STRIDE + kk * 32 + 32 + h * 16);
                    at = mfma32(ka, qb, at); at2 = mfma32(ka2, qb2, at2); }
#pragma unroll
                for (int i = 0; i < 16; ++i) { const int srow = (i & 3) + 8 * (i >> 2) + 4 * h; at[i] = srow > r ? 0.f : at[i] + at2[i]; }
#pragma unroll
                for (int i = 0; i < 16; ++i) o[i] = 0.f;
#pragma unroll
                for (int jj = 0; jj < 2; ++jj) { const LAS unsigned char* vp = gl + SG_VT + (32 * ws + r) * ST_STRIDE + (16 * jj + 4 * h) * 2;
                    o = mfma32(cat4(*(const LAS s16x4*)vp, *(const LAS s16x4*)(vp + 16)), pack8(at, jj), o); }
#pragma unroll
                for (int Tt = 0; Tt < 4; ++Tt)
#pragma unroll
                    for (int jj = 0; jj < 2; ++jj) { const LAS unsigned char* qp = gl + SG_QH + r * SQ_STRIDE + (32 * Tt + 16 * jj + 4 * h) * 2;
                        o = mfma32(pack8(S[Tt], jj), cat4(*(const LAS s16x4*)qp, *(const LAS s16x4*)(qp + 16)), o); }
            }
#pragma unroll
            for (int Tt = 0; Tt < 4; ++Tt) {
#pragma unroll
                for (int g4 = 0; g4 < 4; ++g4) { const f32x4 dl = *(const LAS f32x4*)(gl + SG_DL + (32 * Tt + 8 * g4 + 4 * h) * 4);
                    S[Tt][4 * g4] *= dl.x; S[Tt][4 * g4 + 1] *= dl.y; S[Tt][4 * g4 + 2] *= dl.z; S[Tt][4 * g4 + 3] *= dl.w; }
#pragma unroll
                for (int jj = 0; jj < 2; ++jj) { const bf16x8 ka = *(const LAS bf16x8*)(gl + SG_KT + (32 * Tt + r) * ST_STRIDE + (16 * jj + 8 * h) * 2), vbq = *(const LAS bf16x8*)(gl + SG_VT + (32 * ws + r) * ST_STRIDE + (16 * jj + 8 * h) * 2);
                    S[Tt] = mfma32(ka, vbq, S[Tt]); }
            }
            if (full) {
                if (!second) {
#pragma unroll
                    for (int g4 = 0; g4 < 4; ++g4) { f32x4 vv; vv.x = o[4 * g4]; vv.y = o[4 * g4 + 1]; vv.z = o[4 * g4 + 2]; vv.w = o[4 * g4 + 3]; *(f32x4*)(OS + obase + 8 * g4) = vv; }
                    if (s == 3) asm volatile("s_waitcnt vmcnt(0)" ::: "memory");
                } else {
                    float ssq = 0.f;
#pragma unroll
                    for (int g4 = 0; g4 < 4; ++g4) { const f32x4 pp = pv[g4];
                        o[4 * g4] += pp.x; o[4 * g4 + 1] += pp.y; o[4 * g4 + 2] += pp.z; o[4 * g4 + 3] += pp.w;
                        ssq += (o[4 * g4] * o[4 * g4] + o[4 * g4 + 1] * o[4 * g4 + 1]) + (o[4 * g4 + 2] * o[4 * g4 + 2] + o[4 * g4 + 3] * o[4 * g4 + 3]); }
                    ssq += __shfl_xor(ssq, 32);
                    if (h == 0) *(LAS float*)(gl + SG_SSQ + (r * 4 + ws) * 4) = ssq;
                    __syncthreads();
                    const f32x4 sq = *(const LAS f32x4*)(gl + SG_SSQ + r * 16);
                    const float rstd = __builtin_amdgcn_rsqf(((sq.x + sq.y) + (sq.z + sq.w)) * (1.0f / 128.0f) + EPS);
#pragma unroll
                    for (int g4 = 0; g4 < 4; ++g4) { const u32x2 gg = gv[g4]; const f32x4 gn = *(const f32x4*)(gnorm + 32 * ws + 4 * h + 8 * g4);
                        const float g0 = __uint_as_float(gg.x << 16), g1 = __uint_as_float(gg.x & 0xffff0000u), g2 = __uint_as_float(gg.y << 16), g3 = __uint_as_float(gg.y & 0xffff0000u);
                        u32x2 wv; wv.x = cvtpk(o[4 * g4] * rstd * gn.x * fsigmoid(g0), o[4 * g4 + 1] * rstd * gn.y * fsigmoid(g1));
                        wv.y = cvtpk(o[4 * g4 + 2] * rstd * gn.z * fsigmoid(g2), o[4 * g4 + 3] * rstd * gn.w * fsigmoid(g3));
                        *(u32x2*)(OB + obase + 8 * g4) = wv; }
                }
            }
            if (s + 1 < 8) SC_LSTORE();
            __syncthreads();
        }
#undef SC_GLOAD
#undef SC_LSTORE
#undef SC_TOK
        if (!full) {
            float* sp = SLOC + (size_t)(p * 2 + g) * 16384 + 32 * ws + r;
#pragma unroll
            for (int Tt = 0; Tt < 4; ++Tt)
#pragma unroll
                for (int i = 0; i < 16; ++i) sp[(32 * Tt + (i & 3) + 8 * (i >> 2) + 4 * h) * 128] = S[Tt][i];
            if (th == 0 && ws == 0) { }
            if (th == 0) DSEG[(size_t)(p * 2 + g) * 128 + kc] = fexp(bsum);
        } else if (!sample) {
            float* sp = st_out + (size_t)((b * 2 + g) * 8 + head) * 16384 + 32 * ws + r;
#pragma unroll
            for (int Tt = 0; Tt < 4; ++Tt)
#pragma unroll
                for (int i = 0; i < 16; ++i) sp[(32 * Tt + (i & 3) + 8 * (i >> 2) + 4 * h) * 128] = S[Tt][i];
        }
    }
}

#define GAS __attribute__((address_space(1)))
#define XB_TMO      128
#define XB_XCNT(j)  (256  + 64 * (j))
#define XB_XSUB(j)  (1280 + 64 * (j))
#define XB_XGEN(j)  (2304 + 64 * (j))
#define XB_TOP      3328
#define XB_TOPGEN   3392
#define XCD_BAR_WORDS 3456
#define XB_SPIN_CAP (1u << 18)

__device__ __forceinline__ unsigned xb_ld(unsigned* p)              { return __hip_atomic_load(p, __ATOMIC_RELAXED, __HIP_MEMORY_SCOPE_AGENT); }
__device__ __forceinline__ unsigned xb_add(unsigned* p, unsigned v) { return __hip_atomic_fetch_add(p, v, __ATOMIC_RELAXED, __HIP_MEMORY_SCOPE_AGENT); }
__device__ __forceinline__ unsigned xb_xcc_id() { return (unsigned)__builtin_amdgcn_s_getreg((3 << 11) | 20) & 0xFu; }
#define XB_SPIN(cond, bar) do { unsigned _sp = 0; while (cond) { __builtin_amdgcn_s_sleep(1); \
    if ((++_sp & 255u) == 0u) { if (xb_ld(&(bar)[XB_TMO])) break; if (_sp > XB_SPIN_CAP) { atomicAdd(&(bar)[XB_TMO], 1u); break; } } } } while (0)

struct XcdBarrier {
    unsigned* bar; unsigned x;
    volatile LAS unsigned* st;
};

__device__ __forceinline__ XcdBarrier xcd_barrier_post(unsigned* bar, volatile LAS unsigned* st) {
    XcdBarrier b; b.bar = bar; b.x = xb_xcc_id(); b.st = st;
    if (threadIdx.x == 0) (void)xb_add(&bar[XB_XCNT(b.x)], 1u);
    return b;
}
__device__ __forceinline__ void xcd_barrier_complete(unsigned* bar, unsigned x, unsigned& nloc, unsigned& nx) {
    const unsigned G = gridDim.x * gridDim.y * gridDim.z;
    unsigned sum, cnt, mine, sp = 0u;
    for (;;) {
        sum = 0u; cnt = 0u; mine = 0u;
#pragma unroll
        for (unsigned j = 0; j < 16; ++j) { const unsigned c = xb_ld(&bar[XB_XCNT(j)]); sum += c; cnt += (c > 0u) ? 1u : 0u; mine = (j == x) ? c : mine; }
        if (sum == G) break;
        __builtin_amdgcn_s_sleep(1);
        if ((++sp & 255u) == 0u) { if (xb_ld(&bar[XB_TMO])) break; if (sp > XB_SPIN_CAP) { atomicAdd(&bar[XB_TMO], 1u); break; } }
    }
    nloc = mine > 0u ? mine : 1u; nx = cnt > 0u ? cnt : 1u;
}

__device__ __forceinline__ void xcd_barrier(const XcdBarrier& b) {
    asm volatile("s_waitcnt vmcnt(0)" ::: "memory");
    __syncthreads();
    if (threadIdx.x == 0) {
        unsigned* bar = b.bar;
        __builtin_amdgcn_s_waitcnt(0);
        unsigned nloc = b.st[0], nx = b.st[1];
        if (nloc == 0u) { xcd_barrier_complete(bar, b.x, nloc, nx); b.st[0] = nloc; b.st[1] = nx; }
        const unsigned old = xb_add(&bar[XB_XSUB(b.x)], 1u);
        const unsigned gen = old / nloc;
        if (old + 1u == (gen + 1u) * nloc) {
            __builtin_amdgcn_fence(__ATOMIC_RELEASE, "agent");
            asm volatile("s_waitcnt vmcnt(0)" ::: "memory");
            const unsigned og = xb_add(&bar[XB_TOP], 1u);
            const unsigned tg = og / nx;
            if (og + 1u == (tg + 1u) * nx) xb_add(&bar[XB_TOPGEN], 1u);
            else XB_SPIN(xb_ld(&bar[XB_TOPGEN]) == tg, bar);
            __builtin_amdgcn_fence(__ATOMIC_ACQUIRE, "agent");
            xb_add(&bar[XB_XGEN(b.x)], 1u);
            asm volatile("s_waitcnt vmcnt(0)" ::: "memory");
        } else {
            XB_SPIN(xb_ld(&bar[XB_XGEN(b.x)]) == gen, bar);
            __builtin_amdgcn_fence(__ATOMIC_ACQUIRE, "agent");
            asm volatile("s_waitcnt vmcnt(0)" ::: "memory");
        }
    }
    __syncthreads();
}


struct Args {
    const float *xp, *xs, *cache_k, *cache_v, *state, *c, *cctx, *wmod, *bmod, *normg, *ffn_in, *ffn_out, *attn_in, *attn_out, *attn_lam, *attn_subln, *hgrn_in, *hgrn_out, *hgrn_lb, *hgrn_gn;
    float* out; unsigned char* ws;
};
constexpr int LDS_BYTES = 147456, MISC_OFF = 146432, STAMP_OFF = MISC_OFF + 256;
constexpr size_t OUT_NCK = (size_t)T * D, OUT_NCV = OUT_NCK + (size_t)TP * D, OUT_ST = OUT_NCV + (size_t)TP * D;

typedef const __attribute__((address_space(4))) Args* KArgs;
constexpr int CV_FIN = 16 * 88, CV_FOUT = 44 * 16, CV_AIN = 16 * 48, CV_SQ = 16 * 16, CV_HIN = 16 * 80;
constexpr int CV0 = 0, CV1 = CV0 + CV_FIN  , CV2 = CV1 + CV_FOUT  , CV3 = CV2 + CV_AIN  , CV4 = CV3 + CV_SQ  , CV5 = CV4 + CV_FIN  , CV6 = CV5 + CV_FOUT  ,
              CV7 = CV6 + CV_FIN  , CV8 = CV7 + CV_FOUT  , CV9 = CV8 + CV_SQ  , CV10 = CV9 + CV_HIN  , CV11 = CV10 + CV_FIN  , CV12 = CV11 + CV_FOUT  ;
DI int cv_seg_lo(int sg) { return sg == 0 ? CV0 : sg == 1 ? CV1 : sg == 2 ? CV3 : sg == 3 ? CV5 : sg == 4 ? CV7 : sg == 5 ? CV9 : sg == 6 ? CV11 : CV10; }
DI int cv_seg_hi(int sg) { return sg == 0 ? CV1 : sg == 1 ? CV3 : sg == 2 ? CV5 : sg == 3 ? CV7 : sg == 4 ? CV9 : sg == 5 ? CV10 : sg == 6 ? CV12 : CV11; }
DI void convert_range(KArgs a, LAS unsigned char* lds, int lo, int hi, int wrank, int nw, int wave, int lane) {
    unsigned char* ws = a->ws;
    LAS float* scr = (LAS float*)(lds + wave * 16640);
    for (int it = lo + wrank; it < hi; it += nw) {
        if (it < CV1) transpose_item(a->ffn_in, D, 2 * FH, (bf16*)(ws + WS_FIN00), true, scr, it - CV0, lane);
        else if (it < CV2) transpose_item(a->ffn_out, FH, D, (bf16*)(ws + WS_FOUT00), false, scr, it - CV1, lane);
        else if (it < CV3) transpose_item(a->attn_in, D, 3 * D, (bf16*)(ws + WS_AIN), false, scr, it - CV2, lane);
        else if (it < CV4) transpose_item(a->attn_out, D, D, (bf16*)(ws + WS_AOUT), false, scr, it - CV3, lane);
        else if (it < CV5) transpose_item(a->ffn_in + (size_t)1 * D * (2 * FH), D, 2 * FH, (bf16*)(ws + WS_FIN01), true, scr, it - CV4, lane);
        else if (it < CV6) transpose_item(a->ffn_out + (size_t)1 * FH * D, FH, D, (bf16*)(ws + WS_FOUT01), false, scr, it - CV5, lane);
        else if (it < CV7) transpose_item(a->ffn_in + (size_t)2 * D * (2 * FH), D, 2 * FH, (bf16*)(ws + WS_FIN10), true, scr, it - CV6, lane);
        else if (it < CV8) transpose_item(a->ffn_out + (size_t)2 * FH * D, FH, D, (bf16*)(ws + WS_FOUT10), false, scr, it - CV7, lane);
        else if (it < CV9) transpose_item(a->hgrn_out, D, D, (bf16*)(ws + WS_HOUT), false, scr, it - CV8, lane);
        else if (it < CV10) transpose_item(a->hgrn_in, D, 5 * D, (bf16*)(ws + WS_HIN), false, scr, it - CV9, lane);
        else if (it < CV11) transpose_item(a->ffn_in + (size_t)3 * D * (2 * FH), D, 2 * FH, (bf16*)(ws + WS_FIN11), true, scr, it - CV10, lane);
        else transpose_item(a->ffn_out + (size_t)3 * FH * D, FH, D, (bf16*)(ws + WS_FOUT11), false, scr, it - CV11, lane);
    }
}
#define CONVERT_IDLE(nwg_, sg_) do { const int _sg = (sg_); if (_sg >= 0) { const int _rem = (nwg_) % G, _c = (int)blockIdx.x; \
        if (_rem == 0 || _c >= _rem) { const int _tid = TIDV(), _wave = __builtin_amdgcn_readfirstlane(_tid >> 6); \
            convert_range(KA(), lds, cv_seg_lo(_sg), cv_seg_hi(_sg), (_rem == 0 ? _c : _c - _rem) * 8 + _wave, (_rem == 0 ? G : G - _rem) * 8, _wave, _tid & 63); } } } while (0)
#define KA() ({ KArgs _p = (KArgs)__builtin_amdgcn_kernarg_segment_ptr(); asm volatile("" : "+s"(_p)); _p; })
__global__ void __launch_bounds__(512) fwd_kernel(Args a_unused) {
    extern __shared__ __attribute__((aligned(16))) unsigned char lds_raw[];
    LAS unsigned char* lds = (LAS unsigned char*)lds_raw;
    cg::grid_group grid = cg::this_grid();
    const int G = gridDim.x;
    if (threadIdx.x < 64) ((volatile LAS unsigned*)(lds + MISC_OFF))[threadIdx.x] = 0u;
    __syncthreads();
    int nst = 0; STAMP();
    const XcdBarrier xbar = xcd_barrier_post((unsigned*)KA()->ws, (volatile LAS unsigned*)(lds + MISC_OFF) + 8);
#define TIDV() ({ int _t = threadIdx.x; asm volatile("" : "+v"(_t)); _t; })

    for (int rep = 0; rep < REP_P0; ++rep) {
        __syncthreads();
        KArgs a = KA(); unsigned char* ws = a->ws; float* MOD = (float*)(ws + WS_MOD);
        const int tid = TIDV(), lane = tid & 63, wave = __builtin_amdgcn_readfirstlane(tid >> 6), gw = blockIdx.x * 8 + wave, NGW = G * 8;
        LAS float* sv = (LAS float*)lds; LAS float* red = (LAS float*)(lds + 20480);
        if (blockIdx.x < 72) {
            for (int i = tid; i < 5 * D; i += 512) { const int mi = i >> 10, d = i & 1023; const float x = mi ? a->c[(mi - 1) * D + d] : a->cctx[d]; sv[i] = x * fsigmoid(x); }
            __syncthreads();
            for (int unit = blockIdx.x; unit < 72; unit += G) {
                const int l = unit / 36, cb = unit % 36, col = cb * 256 + 4 * lane;
                const float* wp = a->wmod + (size_t)l * D * NMODE + (size_t)(128 * wave) * NMODE + col;
                f32x4 ac[5];
#pragma unroll
                for (int m = 0; m < 5; ++m) ac[m] = (f32x4){0.f, 0.f, 0.f, 0.f};
#pragma unroll 16
                for (int d = 0; d < 128; ++d) { const f32x4 wv = *(const f32x4*)(wp + (size_t)d * NMODE); const int dd = 128 * wave + d;
#pragma unroll
                    for (int m = 0; m < 5; ++m) ac[m] += wv * sv[m * D + dd]; }
#pragma unroll
                for (int m = 0; m < 5; ++m) *(LAS f32x4*)(red + (wave * 5 + m) * 256 + 4 * lane) = ac[m];
                __syncthreads();
                for (int o = tid; o < 5 * 256; o += 512) { const int mi = o >> 8, cl = o & 255; float sacc = 0.f;
#pragma unroll
                    for (int ww = 0; ww < 8; ++ww) sacc += red[(ww * 5 + mi) * 256 + cl];
                    MOD[(size_t)(l * 5 + mi) * NMODE + cb * 256 + cl] = sacc + a->bmod[l * NMODE + cb * 256 + cl]; }
                __syncthreads();
            }
        }
        if (G > 144) { if (blockIdx.x >= 72) convert_range(a, lds, cv_seg_lo(0), cv_seg_hi(0), gw - 72 * 8, NGW - 72 * 8, wave, lane); }
        else convert_range(a, lds, cv_seg_lo(0), cv_seg_hi(0), gw, NGW, wave, lane);
    }
    if (G == 0x7fffff) grid.sync();
    xcd_barrier(xbar);
    STAMP();
#define NORM(YY, HH, lpost, jpost, gpost_i, resw, lpre, jpre, gpre_i) NORMX(false, YY, HH, lpost, jpost, gpost_i, resw, lpre, jpre, gpre_i)
#define NORMX(FIRST, YY, HH, lpost, jpost, gpost_i, resw, lpre, jpre, gpre_i) do { for (int _nr = 0; _nr < REP_NORM; ++_nr) { KArgs a = KA(); unsigned char* ws = a->ws; float* MOD = (float*)(ws + WS_MOD); float* X = a->out; \
        const int tid = TIDV(), lane = tid & 63, wave = __builtin_amdgcn_readfirstlane(tid >> 6); \
        norm_phase(((FIRST) && _nr == 0) ? a->xp : X, ((FIRST) && _nr == 0) ? a->xs : X + (size_t)TP * D, (YY) ? (const bf16*)(ws + WS_Y) : nullptr, X, (HH) ? (bf16*)(ws + WS_H) : nullptr, MOD + (size_t)(lpost) * 5 * NMODE, (jpost), a->normg + (size_t)(gpost_i) * D, _nr ? 0.f : (resw), \
                   MOD + (size_t)(lpre) * 5 * NMODE, (jpre), a->normg + (size_t)(gpre_i) * D, ((G % 8 == 0) ? ((int)blockIdx.x % 8) * (G / 8) + (int)blockIdx.x / 8 : (int)blockIdx.x) * 8 + wave, G * 8, lane); } } while (0)
    { KArgs a = KA(); unsigned char* ws = a->ws; float* MOD = (float*)(ws + WS_MOD);
      const int tid = TIDV(), lane = tid & 63, wave = __builtin_amdgcn_readfirstlane(tid >> 6);
      norm_phase(a->xp, a->xs, nullptr, nullptr, (bf16*)(ws + WS_H), MOD, 0, a->normg, 0.f, MOD, 0, a->normg, blockIdx.x * 8 + wave, G * 8, lane); }
    GSYNC();
    for (int l = 0; l < 2; ++l) {
        for (int half = 0; half < 2; ++half) {
            for (int rep = 0; rep < REP_FIN; ++rep) {
                unsigned char* ws = KA()->ws;
                const bf16* Wt = (const bf16*)(ws + (l == 0 ? (half ? WS_FIN01 : WS_FIN00) : (half ? WS_FIN11 : WS_FIN10)));
                pg8::Gemm g{(const bf16*)(ws + WS_H), Wt, T, 2 * FH, D}; pg8::StaticOrder S; S.init(T, 2 * FH, G, (int)blockIdx.x);
                EpiSwiglu E{(bf16*)(ws + WS_ACT)};
                pg8::gemm_phase<EpiSwiglu, pg8::StaticOrder, true, true>(lds, g, S, E);
                CONVERT_IDLE(48 * 22, l == 0 ? (half == 0 ? 1 : 5) : (half == 0 ? 7 : -1));
            }
            GSYNC();
            for (int rep = 0; rep < REP_FOUT; ++rep) {
                unsigned char* ws = KA()->ws;
                const bf16* Wt = (const bf16*)(ws + (l == 0 ? (half ? WS_FOUT01 : WS_FOUT00) : (half ? WS_FOUT11 : WS_FOUT10)));
                pg8::Gemm g{(const bf16*)(ws + WS_ACT), Wt, T, D, FH}; pg8::StaticOrder S; S.init(T, D, G, (int)blockIdx.x);
                EpiF32 E{(bf16*)(ws + WS_Y)};
                pg8::gemm_phase<EpiF32, pg8::StaticOrder, true, true>(lds, g, S, E);
                CONVERT_IDLE(48 * 4, l == 0 ? (half == 0 ? 2 : 6) : -1);
            }
            GSYNC();
            if (half == 0) NORMX(l == 0, true, true, l, 0, l * 6 + 1, 0.5f, l, 1, l * 6 + 2);
            else if (l == 0) NORM(true, true, 0, 2, 5, 0.5f, 1, 0, 6);
            else NORM(true, false, 1, 2, 11, 0.5f, 1, 0, 6);
            if (half == 1) { if (l == 0) GSYNC(); continue; }
            GSYNC();
            if (l == 0) {
                for (int rep = 0; rep < REP_MIXG; ++rep) { KArgs a = KA(); unsigned char* ws = a->ws;
                  pg8::Gemm g{(const bf16*)(ws + WS_H), (const bf16*)(ws + WS_AIN), T, 3 * D, D}; pg8::StaticOrder S; S.init(T, 3 * D, G, (int)blockIdx.x);
                  EpiQKV E{(bf16*)(ws + WS_Q), (bf16*)(ws + WS_K), (bf16*)(ws + WS_V), a->out + OUT_NCK, a->out + OUT_NCV};
                  pg8::gemm_phase<EpiQKV, pg8::StaticOrder, true, true>(lds, g, S, E);
                  CONVERT_IDLE(48 * 12, 3);
                  const int tid = TIDV();
                  bf16* Kc = (bf16*)(ws + WS_K) + (size_t)T * D; bf16* Vc = (bf16*)(ws + WS_V) + (size_t)T;
                  const float* ck = a->cache_k; const float* cv = a->cache_v;
                  for (int i = blockIdx.x * 512 + tid; i < 1024 * D / 4; i += G * 512) {
                      const f32x4 k4 = *(const f32x4*)(ck + 4 * (size_t)i), v4 = *(const f32x4*)(cv + 4 * (size_t)i);
                      u32x2 kw; kw.x = cvtpk(k4.x, k4.y); kw.y = cvtpk(k4.z, k4.w); const unsigned v01 = cvtpk(v4.x, v4.y), v23 = cvtpk(v4.z, v4.w);
                      *(u32x2*)(Kc + 4 * (size_t)i) = kw;
                      bf16* vt = Vc + (size_t)((4 * i) & 1023) * VTLD + ((4 * i) >> 10);
                      vt[0] = (bf16)(v01 & 0xffffu); vt[VTLD] = (bf16)(v01 >> 16); vt[2 * VTLD] = (bf16)(v23 & 0xffffu); vt[3 * VTLD] = (bf16)(v23 >> 16); }
                }
                GSYNC();
#ifndef NO_ATTN
                for (int rep = 0; rep < REP_ATTN; ++rep) { KArgs a = KA(); unsigned char* ws = a->ws;
                  attn_phase(lds, (const bf16*)(ws + WS_Q), (const bf16*)(ws + WS_K), (const bf16*)(ws + WS_V), (bf16*)(ws + WS_H), a->attn_lam, a->attn_subln); }
#endif
                GSYNC();
                for (int rep = 0; rep < REP_MIXG; ++rep) { unsigned char* ws = KA()->ws;
                  pg8::Gemm g{(const bf16*)(ws + WS_H), (const bf16*)(ws + WS_AOUT), T, D, D}; pg8::StaticOrder S; S.init(T, D, G, (int)blockIdx.x);
                  EpiF32 E{(bf16*)(ws + WS_Y)};
                  pg8::gemm_phase<EpiF32, pg8::StaticOrder, true, true>(lds, g, S, E);
                  CONVERT_IDLE(48 * 4, 4); }
            } else {
                for (int rep = 0; rep < REP_MIXG; ++rep) { KArgs a = KA(); unsigned char* ws = a->ws;
                  pg8::Gemm g{(const bf16*)(ws + WS_H), (const bf16*)(ws + WS_HIN), T, 5 * D, D}; pg8::StaticOrder S; S.init(T, 5 * D, G, (int)blockIdx.x);
                  EpiHgrn E{(bf16*)(ws + WS_HQ), (bf16*)(ws + WS_HI), (bf16*)(ws + WS_HG), (bf16*)(ws + WS_LF), (bf16*)(ws + WS_LB), a->hgrn_lb};
                  pg8::gemm_phase<EpiHgrn, pg8::StaticOrder, true, true>(lds, g, S, E); }
                GSYNC();
#ifndef NO_SCAN
                for (int rep = 0; rep < REP_SCAN; ++rep)
                for (int ph = 0; ph < 2; ++ph) { KArgs a = KA(); unsigned char* ws = a->ws;
                  scan_phase(ph, lds, (const bf16*)(ws + WS_HQ), (const bf16*)(ws + WS_HI), (const bf16*)(ws + WS_HG), (const bf16*)(ws + WS_LF), (const bf16*)(ws + WS_LB), (float*)(ws + WS_Y), (bf16*)(ws + WS_H),
                             a->state, a->out + OUT_ST, a->hgrn_gn, (float*)(ws + WS_SLOC), (float*)(ws + WS_DSEG));
                  if (ph == 0) GSYNC(); }
#endif
                GSYNC();
                for (int rep = 0; rep < REP_MIXG; ++rep) { unsigned char* ws = KA()->ws;
                  pg8::Gemm g{(const bf16*)(ws + WS_H), (const bf16*)(ws + WS_HOUT), T, D, D}; pg8::StaticOrder S; S.init(T, D, G, (int)blockIdx.x);
                  EpiF32 E{(bf16*)(ws + WS_Y)};
                  pg8::gemm_phase<EpiF32, pg8::StaticOrder, true, true>(lds, g, S, E); }
            }
            GSYNC();
            NORM(true, true, l, 1, l * 6 + 3, 1.0f, l, 2, l * 6 + 4);
            GSYNC();
        }
    }
    STAMP();
    if (PROBE_A >= 0 && blockIdx.x == 0 && threadIdx.x == 0) {
        const unsigned long long ta = *(volatile LAS unsigned long long*)(lds + STAMP_OFF + 8 * PROBE_A), tb = *(volatile LAS unsigned long long*)(lds + STAMP_OFF + 8 * PROBE_B);
        const unsigned long long t0 = __builtin_amdgcn_s_memrealtime();
        while (__builtin_amdgcn_s_memrealtime() - t0 < tb - ta) __builtin_amdgcn_s_sleep(8);
    }
}

extern "C" void kernel_launch(void* const* d_in, const int* in_sizes, int n_in, void* d_out, int out_size, void* d_ws, size_t ws_size, hipStream_t stream) {
    static int grid = 0;
    if (!grid) {
        int dev = 0, cus = 0, per = 0;
        (void)hipGetDevice(&dev);
        (void)hipDeviceGetAttribute(&cus, hipDeviceAttributeMultiprocessorCount, dev);
        (void)hipFuncSetAttribute((const void*)fwd_kernel, hipFuncAttributeMaxDynamicSharedMemorySize, LDS_BYTES);
        (void)hipOccupancyMaxActiveBlocksPerMultiprocessor(&per, (const void*)fwd_kernel, 512, LDS_BYTES);
        if (per < 1) fprintf(stderr, "kernel_launch: occupancy query says %d blocks per CU\n", per);
        grid = cus > 0 ? cus : 256;
        if (ws_size < 280u * 1024u * 1024u) fprintf(stderr, "kernel_launch: workspace too small (%zu)\n", ws_size);
    }
    Args a{};
    a.xp = (const float*)d_in[0]; a.xs = (const float*)d_in[1]; a.cache_k = (const float*)d_in[2]; a.cache_v = (const float*)d_in[3]; a.state = (const float*)d_in[4];
    a.c = (const float*)d_in[5]; a.cctx = (const float*)d_in[6]; a.wmod = (const float*)d_in[7]; a.bmod = (const float*)d_in[8]; a.normg = (const float*)d_in[9];
    a.ffn_in = (const float*)d_in[10]; a.ffn_out = (const float*)d_in[11]; a.attn_in = (const float*)d_in[12]; a.attn_out = (const float*)d_in[13];
    a.attn_lam = (const float*)d_in[14]; a.attn_subln = (const float*)d_in[15]; a.hgrn_in = (const float*)d_in[16]; a.hgrn_out = (const float*)d_in[17];
    a.hgrn_lb = (const float*)d_in[18]; a.hgrn_gn = (const float*)d_in[19];
    a.out = (float*)d_out; a.ws = (unsigned char*)d_ws;
    (void)hipMemsetAsync(d_ws, 0, 16384, stream);
    void* args[] = {&a};
    hipError_t e = hipLaunchCooperativeKernel((void*)fwd_kernel, dim3(grid), dim3(512), args, LDS_BYTES, stream);
    if (e != hipSuccess) fprintf(stderr, "kernel_launch: cooperative launch failed: %s (grid %d)\n", hipGetErrorString(e), grid);
}
```

```cpp
#include <hip/hip_runtime.h>
#include <hip/hip_cooperative_groups.h>
#include <cstdio>
#include <cstdint>
namespace cg = cooperative_groups;
#ifndef REP_P0
#define REP_P0 1
#endif
#ifndef REP_ATTN
#define REP_ATTN 1
#endif
#ifndef REP_SCAN
#define REP_SCAN 1
#endif
#ifndef REP_FIN
#define REP_FIN 1
#endif
#ifndef REP_FOUT
#define REP_FOUT 1
#endif
#ifndef REP_NORM
#define REP_NORM 1
#endif
#ifndef REP_MIXG
#define REP_MIXG 1
#endif
#ifndef PROBE_A
#define PROBE_A -1
#endif
#ifndef PROBE_B
#define PROBE_B -1
#endif
#ifndef REP_SYNC
#define REP_SYNC 1
#endif
#define STAMP() do { if (PROBE_A >= 0 && blockIdx.x == 0 && threadIdx.x == 0) { *(volatile LAS unsigned long long*)(lds + STAMP_OFF + 8 * nst) = __builtin_amdgcn_s_memrealtime(); } ++nst; } while (0)
#define GSYNC() do { for (int _r = 0; _r < REP_SYNC; ++_r) xcd_barrier(xbar); STAMP(); } while (0)
namespace pg8 {
#define PG8_LAS __attribute__((address_space(3)))
typedef unsigned short bf16_t;
typedef short bf16x8 __attribute__((ext_vector_type(8)));
typedef float f32x4 __attribute__((ext_vector_type(4)));
typedef unsigned u32x4 __attribute__((ext_vector_type(4)));
constexpr int BM = 256, BK = 64, HALF = 128, HTB = HALF * BK * 2  , STAGE_BYTES = 8 * HTB, NXCD = 8, WGM = 8;

__host__ __device__ __forceinline__ int lds_byte(int r, int c) { const int st = (r >> 4) * 2 + (c >> 5), rr = r & 15, cc = c & 31, ob = rr * 64 + cc * 2; return st * 1024 + (ob ^ (((ob >> 9) & 1) << 5)); }
__host__ __device__ __forceinline__ void stage_rc(int b, int& R, int& C) { const int st = b / 1024, sb = b % 1024, swz = sb ^ (((sb >> 9) & 1) << 5); R = (st >> 1) * 16 + swz / 64; C = (st & 1) * 32 + (swz % 64) / 2; }
__host__ __device__ __forceinline__ int perm32(int rho) { const int n = rho >> 4, i = rho & 15; return 8 * (i >> 2) + 4 * n + (i & 3); }

struct Unit { int pm, pn; };
struct Gemm { const bf16_t* A; const bf16_t* Bt; int M, N, K; };

struct StaticOrder {
    int nM, nN, nwg, G, c;
    __host__ __device__ void init(int M, int N, int G_, int c_) { nM = M / BM; nN = N / BM; nwg = nM * nN; G = G_; c = c_; }
    __host__ __device__ bool next(int i, Unit& u) const {
        const long L = (long)i * G + c; if (L >= nwg) return false;
        int wgid = (int)L; { const int q = nwg / NXCD, r = nwg % NXCD, xcd = wgid % NXCD, off = wgid / NXCD; wgid = (xcd < r ? xcd * (q + 1) : r * (q + 1) + (xcd - r) * q) + off; }
        const int nig = WGM * nN, gid = wgid / nig, fm = gid * WGM, gsz = (nM - fm) < WGM ? (nM - fm) : WGM;
        u.pm = fm + ((wgid % nig) % gsz); u.pn = (wgid % nig) / gsz; return true;
    }
    __device__ __forceinline__ void a_ready(const Unit&) const {}
    __device__ __forceinline__ void done(const Unit&) const {}
};
template <class Epi, class Sched, bool ALIGN_EPI = false, bool SP2 = false>
__device__ __forceinline__ void gemm_phase(PG8_LAS unsigned char* lds, const Gemm g, const Sched& S, const Epi& E) {
    int tid_ = threadIdx.x; asm volatile("" : "+v"(tid_));
    const int tid = tid_, wid = __builtin_amdgcn_readfirstlane(tid >> 6), lane = tid & 63, wr = wid >> 2, wc = wid & 3, fr = lane & 15, fq = lane >> 4;
    const int K = g.K, nt = K / BK;
    unsigned voffA[2], voffB[2];
#pragma unroll
    for (int i = 0; i < 2; ++i) { int R, C; stage_rc(tid * 16 + i * 8192, R, C); const int Rb = Epi::PERM ? ((R & ~31) + perm32(R & 31)) : R;
        voffA[i] = (unsigned)(R * K + C) * 2u; voffB[i] = (unsigned)(Rb * K + C) * 2u; }
    const size_t kstep = (size_t)(BK * 2);
    const size_t hstep = (size_t)HALF * K * 2;
    const size_t tstep = 2 * hstep;
    const unsigned ldsw = (unsigned)wid * 1024u;
    const int aoff = lds_byte(wr * 64 + fr, fq * 8), boff = lds_byte(wc * 32 + fr, fq * 8);
#define PG8_SA(b, h) (((b) * 2 + (h)) * HTB)
#define PG8_SB(b, h) ((4 + (b) * 2 + (h)) * HTB)
#define PG8_STAGE(bufoff, gbase, voff) do { _Pragma("unroll") for (int _i = 0; _i < 2; ++_i) \
        __builtin_amdgcn_global_load_lds((const unsigned*)((const char*)(gbase) + (voff)[_i]), (PG8_LAS unsigned*)(lds + (bufoff) + ldsw + _i * 8192), 16, 0, 0); } while (0)
#define PG8_LDA(dst, b, h) do { _Pragma("unroll") for (int m = 0; m < 4; ++m) _Pragma("unroll") for (int k = 0; k < 2; ++k) dst[m][k] = *(const PG8_LAS bf16x8*)(lds + PG8_SA(b, h) + aoff + m * 2048 + k * 1024); } while (0)
#define PG8_LDB(dst, b, h) do { _Pragma("unroll") for (int n = 0; n < 2; ++n) _Pragma("unroll") for (int k = 0; k < 2; ++k) dst[n][k] = *(const PG8_LAS bf16x8*)(lds + PG8_SB(b, h) + boff + n * 2048 + k * 1024); } while (0)
#define PG8_MMA(ai, bj, At, Bt) do { __builtin_amdgcn_s_setprio(1); _Pragma("unroll") for (int m = 0; m < 4; ++m) _Pragma("unroll") for (int n = 0; n < 2; ++n) _Pragma("unroll") for (int k = 0; k < 2; ++k) \
        acc[ai][bj][m][n] = __builtin_amdgcn_mfma_f32_16x16x32_bf16(Bt[n][k], At[m][k], acc[ai][bj][m][n], 0, 0, 0); __builtin_amdgcn_s_setprio(0); } while (0)
#define PG8_WAIT_V(n) asm volatile("s_waitcnt vmcnt(" #n ")" ::: "memory")
#define PG8_WAIT_L(n) asm volatile("s_waitcnt lgkmcnt(" #n ")" ::: "memory")
#define PG8_BAR __builtin_amdgcn_s_barrier()
#define PG8_SCHED __builtin_amdgcn_sched_barrier(0)
    Unit cur, nxt; int ui = 0;
    if (!S.next(0, cur)) return;
    f32x4 acc[2][2][4][2];
#pragma unroll
    for (int a = 0; a < 2; ++a)
#pragma unroll
        for (int b = 0; b < 2; ++b)
#pragma unroll
            for (int m = 0; m < 4; ++m)
#pragma unroll
                for (int n = 0; n < 2; ++n) acc[a][b][m][n] = (f32x4){0.f, 0.f, 0.f, 0.f};
    bf16x8 At[4][2], B0[2][2], B1[2][2];
    const char* cA = (const char*)g.A + (size_t)cur.pm * tstep; const char* cB = (const char*)g.Bt + (size_t)cur.pn * tstep;
    S.a_ready(cur);
    if constexpr (SP2) {
        PG8_STAGE(PG8_SB(0, 0), cB, voffB); PG8_STAGE(PG8_SB(0, 1), cB + hstep, voffB); PG8_STAGE(PG8_SA(0, 0), cA, voffA); PG8_STAGE(PG8_SA(0, 1), cA + hstep, voffA);
        if (wr == 1) PG8_BAR;
        PG8_WAIT_V(2); PG8_BAR;
        PG8_STAGE(PG8_SB(1, 0), cB + kstep, voffB); PG8_STAGE(PG8_SA(1, 0), cA + kstep, voffA); PG8_STAGE(PG8_SB(1, 1), cB + hstep + kstep, voffB);
        PG8_WAIT_V(6); PG8_BAR;
    } else {
        PG8_STAGE(PG8_SB(0, 0), cB, voffB); PG8_STAGE(PG8_SA(0, 0), cA, voffA); PG8_STAGE(PG8_SB(0, 1), cB + hstep, voffB); PG8_STAGE(PG8_SA(0, 1), cA + hstep, voffA);
        if (wr == 1) PG8_BAR;
        PG8_WAIT_V(4); PG8_BAR;
        PG8_STAGE(PG8_SB(1, 0), cB + kstep, voffB); PG8_STAGE(PG8_SA(1, 0), cA + kstep, voffA); PG8_STAGE(PG8_SB(1, 1), cB + hstep + kstep, voffB);
        PG8_WAIT_V(6); PG8_BAR;
    }
    for (;;) {
        const bool has_next = S.next(ui + 1, nxt);
        const char* nA = has_next ? (const char*)g.A + (size_t)nxt.pm * tstep : cA; const char* nB = has_next ? (const char*)g.Bt + (size_t)nxt.pn * tstep : cB;
        for (int t = 0; t < nt; t += 2) {
            const bool last = (t == nt - 2);
            const char* a1 = cA + (size_t)(t + 1) * kstep;
            const char* a2 = last ? nA : cA + (size_t)(t + 2) * kstep; const char* b2 = last ? nB : cB + (size_t)(t + 2) * kstep;
            const char* a3 = a2 + kstep; const char* b3 = b2 + kstep;
            if (last && has_next) S.a_ready(nxt);
            if constexpr (SP2) {
            PG8_LDB(B0, 0, 0); PG8_LDB(B1, 0, 1); PG8_SCHED; PG8_LDA(At, 0, 0); PG8_STAGE(PG8_SA(1, 1), a1 + hstep, voffA);
            PG8_WAIT_V(8); PG8_WAIT_L(0); PG8_BAR; PG8_MMA(0, 0, At, B0); PG8_MMA(0, 1, At, B1); PG8_BAR; PG8_SCHED;
            PG8_LDA(At, 0, 1); PG8_STAGE(PG8_SB(0, 0), b2, voffB); PG8_STAGE(PG8_SB(0, 1), b2 + hstep, voffB); PG8_STAGE(PG8_SA(0, 0), a2, voffA);
            PG8_WAIT_V(8); PG8_WAIT_L(0); PG8_BAR; PG8_MMA(1, 0, At, B0); PG8_MMA(1, 1, At, B1); PG8_BAR; PG8_SCHED;
            PG8_LDB(B0, 1, 0); PG8_LDB(B1, 1, 1); PG8_SCHED; PG8_LDA(At, 1, 0); PG8_STAGE(PG8_SA(0, 1), a2 + hstep, voffA);
            PG8_WAIT_V(8); PG8_WAIT_L(0); PG8_BAR; PG8_MMA(0, 0, At, B0); PG8_MMA(0, 1, At, B1); PG8_BAR; PG8_SCHED;
            PG8_LDA(At, 1, 1); PG8_STAGE(PG8_SB(1, 0), b3, voffB); PG8_STAGE(PG8_SB(1, 1), b3 + hstep, voffB); PG8_STAGE(PG8_SA(1, 0), a3, voffA);
            PG8_WAIT_V(8); PG8_WAIT_L(0); PG8_BAR; PG8_MMA(1, 0, At, B0); PG8_MMA(1, 1, At, B1); PG8_BAR; PG8_SCHED;
            } else {
            PG8_LDB(B0, 0, 0); PG8_SCHED; PG8_LDA(At, 0, 0); PG8_STAGE(PG8_SA(1, 1), a1 + hstep, voffA);
            PG8_WAIT_L(8); PG8_BAR; PG8_WAIT_L(0); PG8_MMA(0, 0, At, B0); PG8_BAR; PG8_SCHED;
            PG8_LDB(B1, 0, 1); PG8_STAGE(PG8_SB(0, 0), b2, voffB);
            PG8_BAR; PG8_WAIT_L(0); PG8_MMA(0, 1, At, B1); PG8_BAR;
            PG8_LDA(At, 0, 1); PG8_STAGE(PG8_SA(0, 0), a2, voffA);
            PG8_BAR; PG8_WAIT_L(0); PG8_MMA(1, 0, At, B0); PG8_BAR; PG8_SCHED;
            PG8_STAGE(PG8_SB(0, 1), b2 + hstep, voffB);
            PG8_WAIT_V(6); PG8_BAR; PG8_MMA(1, 1, At, B1); PG8_BAR;
            PG8_LDB(B0, 1, 0); PG8_SCHED; PG8_LDA(At, 1, 0); PG8_STAGE(PG8_SA(0, 1), a2 + hstep, voffA);
            PG8_WAIT_L(8); PG8_BAR; PG8_WAIT_L(0); PG8_MMA(0, 0, At, B0); PG8_BAR; PG8_SCHED;
            PG8_LDB(B1, 1, 1); PG8_STAGE(PG8_SB(1, 0), b3, voffB);
            PG8_BAR; PG8_WAIT_L(0); PG8_MMA(0, 1, At, B1); PG8_BAR;
            PG8_LDA(At, 1, 1); PG8_STAGE(PG8_SA(1, 0), a3, voffA);
            PG8_BAR; PG8_WAIT_L(0); PG8_MMA(1, 0, At, B0); PG8_BAR; PG8_SCHED;
            PG8_STAGE(PG8_SB(1, 1), b3 + hstep, voffB);
            PG8_WAIT_V(6); PG8_BAR; PG8_MMA(1, 1, At, B1); PG8_BAR;
            }
        }
        if constexpr (ALIGN_EPI) { if (wr == 0) PG8_BAR; }
        if constexpr (!Epi::AFTER_DRAIN) { E(acc, cur, wr, wc, fr, fq); S.done(cur); }
        if (!has_next) break;
#pragma unroll
        for (int a = 0; a < 2; ++a)
#pragma unroll
            for (int b = 0; b < 2; ++b)
#pragma unroll
                for (int m = 0; m < 4; ++m)
#pragma unroll
                    for (int n = 0; n < 2; ++n) acc[a][b][m][n] = (f32x4){0.f, 0.f, 0.f, 0.f};
        cur = nxt; cA = nA; cB = nB; ++ui;
        if constexpr (ALIGN_EPI) { if (wr == 1) PG8_BAR; }
    }
    PG8_WAIT_V(0);
    if constexpr (!ALIGN_EPI) { if (wr == 0) PG8_BAR; }
    PG8_BAR;
    if constexpr (Epi::AFTER_DRAIN) { E.fused(acc, cur, wr, wc, fr, fq, lds, wid, lane); S.done(cur); }
#undef PG8_SA
#undef PG8_SB
#undef PG8_STAGE
#undef PG8_LDA
#undef PG8_LDB
#undef PG8_MMA
#undef PG8_WAIT_V
#undef PG8_WAIT_L
#undef PG8_BAR
#undef PG8_SCHED
}
}
#ifndef DI
#define DI __device__ __forceinline__
#endif
#define LAS __attribute__((address_space(3)))
typedef unsigned short bf16;
typedef float f32x2 __attribute__((ext_vector_type(2)));
typedef float f32x4 __attribute__((ext_vector_type(4)));
typedef float f32x16 __attribute__((ext_vector_type(16)));
typedef short bf16x8 __attribute__((ext_vector_type(8)));
typedef short s16x4 __attribute__((ext_vector_type(4)));
typedef unsigned u32x2 __attribute__((ext_vector_type(2)));
typedef unsigned u32x4 __attribute__((ext_vector_type(4)));
typedef __bf16 bf16x2_t __attribute__((ext_vector_type(2)));
DI unsigned cvtpk(float lo, float hi) { f32x2 v = {lo, hi}; bf16x2_t b = __builtin_convertvector(v, bf16x2_t); return __builtin_bit_cast(unsigned, b); }
DI float bf2f(bf16 b) { return __uint_as_float(((unsigned)b) << 16); }
DI float wave_sum(float v) {
#pragma unroll
    for (int o = 1; o < 64; o <<= 1) v += __shfl_xor(v, o);
    return v;
}
DI float fexp(float x) { return __builtin_amdgcn_exp2f(x * 1.4426950408889634f); }
DI float fsigmoid(float x) { return __builtin_amdgcn_rcpf(1.0f + fexp(-x)); }
DI f32x16 mfma32(bf16x8 a, bf16x8 b, f32x16 c) { return __builtin_amdgcn_mfma_f32_32x32x16_bf16(a, b, c, 0, 0, 0); }
DI bf16x8 pack8(const f32x16& x, int s) {
    u32x4 p;
    p[0] = cvtpk(x[8 * s + 0], x[8 * s + 1]); p[1] = cvtpk(x[8 * s + 2], x[8 * s + 3]);
    p[2] = cvtpk(x[8 * s + 4], x[8 * s + 5]); p[3] = cvtpk(x[8 * s + 6], x[8 * s + 7]);
    return __builtin_bit_cast(bf16x8, p);
}
DI bf16x8 cat4(s16x4 lo, s16x4 hi) { return __builtin_shufflevector(lo, hi, 0, 1, 2, 3, 4, 5, 6, 7); }

constexpr int D = 1024, TP = 4096, TSM = 8192, T = TP + TSM, FH = 2816, NMODE = 9 * D;
constexpr float EPS = 1e-6f;
constexpr size_t HM = 512u * 1024u;
constexpr size_t WS_MOD = 1 * HM;
constexpr size_t WS_FIN00 = 4 * HM, WS_FIN01 = 26 * HM, WS_FOUT00 = 48 * HM, WS_FOUT01 = 59 * HM, WS_AIN = 70 * HM, WS_AOUT = 82 * HM;
constexpr size_t WS_FIN10 = 86 * HM, WS_FOUT10 = 108 * HM, WS_HIN = 119 * HM, WS_FIN11 = 139 * HM, WS_FOUT11 = 161 * HM, WS_HOUT = 172 * HM;
constexpr size_t WS_H = 176 * HM;
constexpr size_t WS_Y = 224 * HM;
constexpr size_t WS_BIG = 320 * HM;
constexpr size_t WS_ACT = WS_BIG;
constexpr size_t WS_Q = WS_BIG, WS_K = WS_BIG + 48 * HM, WS_V = WS_K + 52 * HM;
constexpr size_t WS_HQ = WS_BIG, WS_HI = WS_BIG + 48 * HM, WS_HG = WS_BIG + 96 * HM, WS_LF = WS_BIG + 144 * HM, WS_LB = WS_BIG + 192 * HM;
constexpr size_t WS_SLOC = 4 * HM, WS_DSEG = 72 * HM;
struct EpiF32 {
    static constexpr bool PERM = true, AFTER_DRAIN = false;
    bf16* C;
    DI void operator()(const f32x4 (&acc)[2][2][4][2], const pg8::Unit& u, int wr, int wc, int fr, int fq) const {
        const int row0 = u.pm * 256 + wr * 64 + fr, col0 = u.pn * 256 + wc * 32 + 8 * fq;
#pragma unroll
        for (int ai = 0; ai < 2; ++ai)
#pragma unroll
            for (int m = 0; m < 4; ++m) { bf16* rowp = C + (size_t)(row0 + ai * 128 + m * 16) * D + col0;
#pragma unroll
                for (int bj = 0; bj < 2; ++bj) { const f32x4 v0 = acc[ai][bj][m][0], v1 = acc[ai][bj][m][1];
                    u32x4 w; w.x = cvtpk(v0[0], v0[1]); w.y = cvtpk(v0[2], v0[3]); w.z = cvtpk(v1[0], v1[1]); w.w = cvtpk(v1[2], v1[3]); *(u32x4*)(rowp + bj * 128) = w; } }
    }
};
struct EpiSwiglu {
    static constexpr bool PERM = true, AFTER_DRAIN = false;
    bf16* O;
    DI void operator()(const f32x4 (&acc)[2][2][4][2], const pg8::Unit& u, int wr, int wc, int fr, int fq) const {
        const int row0 = u.pm * 256 + wr * 64 + fr, col0 = u.pn * 128 + wc * 32 + 8 * fq;
#pragma unroll
        for (int ai = 0; ai < 2; ++ai)
#pragma unroll
            for (int m = 0; m < 4; ++m) { bf16* rowp = O + (size_t)(row0 + ai * 128 + m * 16) * FH + col0; float rr[8];
#pragma unroll
                for (int n = 0; n < 2; ++n) { const f32x4 a = acc[ai][0][m][n], b = acc[ai][1][m][n];
#pragma unroll
                    for (int j = 0; j < 4; ++j) rr[4 * n + j] = a[j] * fsigmoid(a[j]) * b[j]; }
                u32x4 w; w.x = cvtpk(rr[0], rr[1]); w.y = cvtpk(rr[2], rr[3]); w.z = cvtpk(rr[4], rr[5]); w.w = cvtpk(rr[6], rr[7]); *(u32x4*)rowp = w; }
    }
};
constexpr float QSCALE = 0.125f * 1.4426950408889634f;
constexpr size_t VTLD = (size_t)T + 1024;
struct EpiQKV {
    static constexpr bool PERM = false, AFTER_DRAIN = false;
    bf16 *Qb, *Kb, *Vb; float *nck, *ncv;
    DI void operator()(const f32x4 (&acc)[2][2][4][2], const pg8::Unit& u, int wr, int wc, int fr, int fq) const {
        const int sec = u.pn >> 2; const bool sample = u.pm >= 16;
        const int row0 = u.pm * 256 + wr * 64 + fr, col0 = (u.pn & 3) * 256 + wc * 32 + 4 * fq;
        if (sec == 2) {
#pragma unroll
            for (int ai = 0; ai < 2; ++ai)
#pragma unroll
                for (int m = 0; m < 4; ++m) { const size_t off = (size_t)(row0 + ai * 128 + m * 16) * D + col0;
#pragma unroll
                    for (int bj = 0; bj < 2; ++bj)
#pragma unroll
                        for (int n = 0; n < 2; ++n) { const f32x4 v = acc[ai][bj][m][n]; const unsigned w0 = cvtpk(v[0], v[1]), w1 = cvtpk(v[2], v[3]);
                            bf16* vt = Vb + (size_t)(col0 + bj * 128 + n * 16) * VTLD + (row0 + ai * 128 + m * 16);
                            vt[0] = (bf16)(w0 & 0xffffu); vt[VTLD] = (bf16)(w0 >> 16); vt[2 * VTLD] = (bf16)(w1 & 0xffffu); vt[3 * VTLD] = (bf16)(w1 >> 16);
                            if (!sample) *(f32x4*)(ncv + off + bj * 128 + n * 16) = v; } }
        } else {
            float inv[4];
#pragma unroll
            for (int j = 0; j < 4; ++j) inv[j] = __builtin_amdgcn_exp2f(-(float)(4 * fq + j) * (13.287712379549449f / 16.0f)) * 0.15915494309189535f;
            const int axis = wc & 1;
            bf16* dst = sec == 0 ? Qb : Kb; const float sc = sec == 0 ? QSCALE : 1.0f;
#pragma unroll
            for (int ai = 0; ai < 2; ++ai)
#pragma unroll
                for (int m = 0; m < 4; ++m) { const int row = row0 + ai * 128 + m * 16; const size_t off = (size_t)row * D + col0;
                    const int t = (row - TP) & 2047; const float pos = (float)(axis ? (t & 63) : (t >> 6));
                    float cs[4], sn[4];
#pragma unroll
                    for (int j = 0; j < 4; ++j) { const float rev = __builtin_amdgcn_fractf(pos * inv[j]); cs[j] = sample ? __builtin_amdgcn_cosf(rev) : 1.0f; sn[j] = sample ? __builtin_amdgcn_sinf(rev) : 0.0f; }
#pragma unroll
                    for (int bj = 0; bj < 2; ++bj) { const f32x4 x1 = acc[ai][bj][m][0], x2 = acc[ai][bj][m][1]; f32x4 o1, o2;
#pragma unroll
                        for (int j = 0; j < 4; ++j) { o1[j] = x1[j] * cs[j] - x2[j] * sn[j]; o2[j] = x1[j] * sn[j] + x2[j] * cs[j]; }
                        if (sec == 1 && !sample) { *(f32x4*)(nck + off + bj * 128) = o1; *(f32x4*)(nck + off + bj * 128 + 16) = o2; }
                        u32x2 w1, w2; w1.x = cvtpk(o1[0] * sc, o1[1] * sc); w1.y = cvtpk(o1[2] * sc, o1[3] * sc); w2.x = cvtpk(o2[0] * sc, o2[1] * sc); w2.y = cvtpk(o2[2] * sc, o2[3] * sc);
                        *(u32x2*)(dst + off + bj * 128) = w1; *(u32x2*)(dst + off + bj * 128 + 16) = w2; } }
        }
    }
};
struct EpiHgrn {
    static constexpr bool PERM = true, AFTER_DRAIN = false;
    bf16 *HQ, *HI, *HG, *LF, *LB; const float* hlb;
    DI void operator()(const f32x4 (&acc)[2][2][4][2], const pg8::Unit& u, int wr, int wc, int fr, int fq) const {
        const int sec = u.pn >> 2;
        const int row0 = u.pm * 256 + wr * 64 + fr, col0 = (u.pn & 3) * 256 + wc * 32 + 8 * fq;
        if (sec == 1 || sec == 2) {
            const int dir = sec - 1; bf16* L = dir ? LB : LF;
#pragma unroll
            for (int bj = 0; bj < 2; ++bj) { const int col = col0 + bj * 128; float lb[8];
#pragma unroll
                for (int n = 0; n < 2; ++n) { const f32x4 p0 = *(const f32x4*)(hlb + dir * 1024 + col + 4 * n), p1 = *(const f32x4*)(hlb + 2048 + dir * 1024 + col + 4 * n);
#pragma unroll
                    for (int j = 0; j < 4; ++j) lb[4 * n + j] = __builtin_amdgcn_rcpf(1.0f + fexp(p0[j] - p1[j])); }
#pragma unroll
                for (int ai = 0; ai < 2; ++ai)
#pragma unroll
                    for (int m = 0; m < 4; ++m) { float o[8];
#pragma unroll
                        for (int n = 0; n < 2; ++n) { const f32x4 z = acc[ai][bj][m][n];
#pragma unroll
                            for (int j = 0; j < 4; ++j) { const float f = lb[4 * n + j] + (1.0f - lb[4 * n + j]) * fsigmoid(z[j]); o[4 * n + j] = __builtin_amdgcn_logf(f) * 0.6931471805599453f; } }
                        u32x4 wl; wl.x = cvtpk(o[0], o[1]); wl.y = cvtpk(o[2], o[3]); wl.z = cvtpk(o[4], o[5]); wl.w = cvtpk(o[6], o[7]);
                        *(u32x4*)(L + (size_t)(row0 + ai * 128 + m * 16) * D + col) = wl; } }
        } else {
            bf16* dst = HQ + (size_t)(sec == 0 ? 0 : sec - 2) * ((size_t)T * D);
#pragma unroll
            for (int ai = 0; ai < 2; ++ai)
#pragma unroll
                for (int m = 0; m < 4; ++m) { const size_t off = (size_t)(row0 + ai * 128 + m * 16) * D + col0;
#pragma unroll
                    for (int bj = 0; bj < 2; ++bj) { const f32x4 v0 = acc[ai][bj][m][0], v1 = acc[ai][bj][m][1];
                        u32x4 w; w.x = cvtpk(v0[0], v0[1]); w.y = cvtpk(v0[2], v0[3]); w.z = cvtpk(v1[0], v1[1]); w.w = cvtpk(v1[2], v1[3]); *(u32x4*)(dst + off + bj * 128) = w; } }
        }
    }
};
DI void transpose_item(const float* W, int K, int N, bf16* WT, bool swig, LAS float* scr, int item, int lane) {
    const int nblk = N / 64, kb = item / nblk, nb = item % nblk, k0 = 64 * kb, n0 = 64 * nb;
    int r0 = n0;
    if (swig) { const int bj = n0 >= FH ? 1 : 0, uu = n0 - bj * FH; r0 = 256 * (uu >> 7) + 128 * bj + (uu & 127); }
    const int lk = lane >> 4, ln = (lane & 15) * 4;
    f32x4 t[16];
#pragma unroll
    for (int i = 0; i < 16; ++i) t[i] = __builtin_nontemporal_load((const f32x4*)(W + (size_t)(k0 + 4 * i + lk) * N + n0 + ln));
#pragma unroll
    for (int i = 0; i < 16; ++i) { LAS float* d = scr + (4 * i + lk) * 65 + ln; d[0] = t[i].x; d[1] = t[i].y; d[2] = t[i].z; d[3] = t[i].w; }
    asm volatile("s_waitcnt lgkmcnt(0)" ::: "memory");
    const int c = lane & 7;
#pragma unroll
    for (int j = 0; j < 8; ++j) { const int n = (lane >> 3) + 8 * j; const LAS float* sp = scr + (8 * c) * 65 + n;
        u32x4 o; o.x = cvtpk(sp[0 * 65], sp[1 * 65]); o.y = cvtpk(sp[2 * 65], sp[3 * 65]); o.z = cvtpk(sp[4 * 65], sp[5 * 65]); o.w = cvtpk(sp[6 * 65], sp[7 * 65]);
        *(u32x4*)(WT + (size_t)(r0 + n) * K + k0 + 8 * c) = o; }
    asm volatile("s_waitcnt lgkmcnt(0)" ::: "memory");
}

DI void norm_phase(const float* xp, const float* xs, const bf16* Y, float* X, bf16* H,
                   const float* modpost, int jpost, const float* gpost, float resw,
                   const float* modpre, int jpre, const float* gpre, int gw, int NGW, int lane) {
    const int rows_per = (T + NGW - 1) / NGW, r0 = gw * rows_per, r1 = (r0 + rows_per) < T ? (r0 + rows_per) : T;
    f32x4 v[4], vn[4], vm[4]; u32x2 yb[4], ybn[4], ybm[4]; f32x4 wv[4], av[4], bv[4]; int cur_mi = -1;
#define NP_LOAD(row_, vv, yy) do { const int _r = (row_); const float* _xr = _r < TP ? xp + (size_t)_r * D : xs + (size_t)(_r - TP) * D; \
        _Pragma("unroll") for (int _j = 0; _j < 4; ++_j) { vv[_j] = *(const f32x4*)(_xr + 4 * lane + 256 * _j); if (Y) yy[_j] = *(const u32x2*)(Y + (size_t)_r * D + 4 * lane + 256 * _j); } } while (0)
#pragma unroll
    for (int j = 0; j < 4; ++j) { yb[j] = (u32x2){0u, 0u}; ybn[j] = (u32x2){0u, 0u}; ybm[j] = (u32x2){0u, 0u}; wv[j] = (f32x4){0.f, 0.f, 0.f, 0.f}; av[j] = wv[j]; bv[j] = wv[j]; vn[j] = wv[j]; vm[j] = wv[j]; }
    if (r0 < r1) NP_LOAD(r0, v, yb);
    if (r0 + 1 < r1) NP_LOAD(r0 + 1, vn, ybn);
    for (int row = r0; row < r1; ++row) {
        const int mi = row < TP ? 0 : 1 + ((row - TP) >> 11);
        if (mi != cur_mi) {
            cur_mi = mi;
            if (Y) { const float* gate = modpost + (size_t)mi * NMODE + (3 * jpost + 2) * D;
#pragma unroll
                for (int j = 0; j < 4; ++j) wv[j] = *(const f32x4*)(gate + 4 * lane + 256 * j) * *(const f32x4*)(gpost + 4 * lane + 256 * j) * resw; }
            if (H) { const float* sh = modpre + (size_t)mi * NMODE + (3 * jpre) * D; const float* sc = sh + D;
#pragma unroll
                for (int j = 0; j < 4; ++j) { av[j] = *(const f32x4*)(sh + 4 * lane + 256 * j); bv[j] = (*(const f32x4*)(sc + 4 * lane + 256 * j) + 1.0f) * *(const f32x4*)(gpre + 4 * lane + 256 * j); } }
        }
        if (row + 2 < r1) NP_LOAD(row + 2, vm, ybm);
        if (Y) {
            f32x4 y[4]; float s = 0.f;
#pragma unroll
            for (int j = 0; j < 4; ++j) { y[j].x = __uint_as_float(yb[j].x << 16); y[j].y = __uint_as_float(yb[j].x & 0xffff0000u); y[j].z = __uint_as_float(yb[j].y << 16); y[j].w = __uint_as_float(yb[j].y & 0xffff0000u);
                s += (y[j].x * y[j].x + y[j].y * y[j].y) + (y[j].z * y[j].z + y[j].w * y[j].w); }
            const float rstd = __builtin_amdgcn_rsqf(wave_sum(s) * (1.0f / D) + EPS);
#pragma unroll
            for (int j = 0; j < 4; ++j) v[j] = v[j] + (y[j] * rstd) * wv[j];
        }
#pragma unroll
        for (int j = 0; j < 4; ++j) { if (X) *(f32x4*)(X + (size_t)row * D + 4 * lane + 256 * j) = v[j]; }
        if (H) {
            float s = 0.f;
#pragma unroll
            for (int j = 0; j < 4; ++j) s += (v[j].x * v[j].x + v[j].y * v[j].y) + (v[j].z * v[j].z + v[j].w * v[j].w);
            const float rstd = __builtin_amdgcn_rsqf(wave_sum(s) * (1.0f / D) + EPS);
#pragma unroll
            for (int j = 0; j < 4; ++j) { const f32x4 hh = (v[j] * rstd) * bv[j] + av[j];
                u32x2 w; w.x = cvtpk(hh.x, hh.y); w.y = cvtpk(hh.z, hh.w); *(u32x2*)(H + (size_t)row * D + 4 * lane + 256 * j) = w; }
        }
#pragma unroll
        for (int j = 0; j < 4; ++j) { v[j] = vn[j]; yb[j] = ybn[j]; vn[j] = vm[j]; ybn[j] = ybm[j]; }
    }
#undef NP_LOAD
}

constexpr int AK_STRIDE = 272, AV_STRIDE = 136, AK_BYTES = 64 * AK_STRIDE, AV_BYTES = 128 * AV_STRIDE;
DI void attn_phase(LAS unsigned char* lds, const bf16* Qb, const bf16* Kb, const bf16* Vb, bf16* OB, const float* lamp, const float* subln) {
    int tid_ = threadIdx.x; asm volatile("" : "+v"(tid_));
    const int tid = tid_, lane = tid & 63, w = __builtin_amdgcn_readfirstlane(tid >> 6), r = lane & 31, h = lane >> 5;
    const int qg = w >> 1, c = w & 1;
    float lam;
    { const float a = lamp[lane] * lamp[64 + lane], b = lamp[128 + lane] * lamp[192 + lane];
      lam = fexp(wave_sum(a)) - fexp(wave_sum(b)) + 0.2f; }
    const float OUTSC = 0.8f;
    const int G_ = gridDim.x, vcu = (G_ % 8 == 0) ? ((int)blockIdx.x % 8) * (G_ / 8) + (int)blockIdx.x / 8 : (int)blockIdx.x;
    for (int u = vcu; u < 768; u += G_) {
        int qrow0, krow0, krow1, nt, nt0, head;
        if (u < 512) { const int b = u >> 7; head = (u >> 4) & 7; const int qb = u & 15; qrow0 = TP + b * 2048 + qb * 128; krow0 = TP + b * 2048; krow1 = T + b * 256; nt0 = 32; nt = 36; }
        else { const int pu = u - 512, b = pu >> 4; head = (pu >> 1) & 7; qrow0 = b * 256 + (pu & 1) * 128; krow0 = b * 256; krow1 = 0; nt0 = 4; nt = 4; }
        const int qrow = qrow0 + 32 * qg + r;
        bf16x8 qf[4];
#pragma unroll
        for (int kk = 0; kk < 4; ++kk) qf[kk] = *(const bf16x8*)(Qb + (size_t)qrow * D + head * 128 + c * 64 + 16 * kk + 8 * h);
        f32x16 O[4];
#pragma unroll
        for (int vt = 0; vt < 4; ++vt)
#pragma unroll
            for (int i = 0; i < 16; ++i) O[vt][i] = 0.f;
        float mrun = 0.f, lrun = 0.f;
        const int kkey = tid >> 3, kch = tid & 7, vrow = tid >> 2, vchk = tid & 3;
        u32x4 kr0, kr1, vr0, vr1;
#define ATT_LOAD(tt) do { const int _t = (tt); const size_t _rowk = (size_t)(_t < nt0 ? krow0 + 64 * _t : krow1 + 64 * (_t - nt0)); \
            const bf16* _kp = Kb + (_rowk + kkey) * D + head * 128 + kch * 16; kr0 = *(const u32x4*)_kp; kr1 = *(const u32x4*)(_kp + 8); \
            const bf16* _vp = Vb + (size_t)(head * 128 + vrow) * VTLD + _rowk + vchk * 16; vr0 = *(const u32x4*)_vp; vr1 = *(const u32x4*)(_vp + 8); } while (0)
#define ATT_STORE(bufi) do { LAS unsigned char* _kb = lds + (bufi) * (AK_BYTES + AV_BYTES); LAS unsigned char* _vb = _kb + AK_BYTES; \
            *(LAS u32x4*)(_kb + kkey * AK_STRIDE + kch * 32) = kr0; *(LAS u32x4*)(_kb + kkey * AK_STRIDE + kch * 32 + 16) = kr1; \
            { LAS unsigned char* _vd = _vb + vrow * AV_STRIDE + vchk * 32; u32x2 _w; \
              _w.x = vr0.x; _w.y = vr0.y; *(LAS u32x2*)_vd = _w; _w.x = vr0.z; _w.y = vr0.w; *(LAS u32x2*)(_vd + 8) = _w; \
              _w.x = vr1.x; _w.y = vr1.y; *(LAS u32x2*)(_vd + 16) = _w; _w.x = vr1.z; _w.y = vr1.w; *(LAS u32x2*)(_vd + 24) = _w; } } while (0)
        ATT_LOAD(0); ATT_STORE(0);
        __syncthreads();
        for (int t = 0; t < nt; ++t) {
            if (t + 1 < nt) ATT_LOAD(t + 1);
            const LAS unsigned char* kb = lds + (t & 1) * (AK_BYTES + AV_BYTES); const LAS unsigned char* vb = kb + AK_BYTES;
            {
                bf16x8 ka[4];
#pragma unroll
                for (int kk = 0; kk < 4; ++kk) ka[kk] = *(const LAS bf16x8*)(kb + r * AK_STRIDE + c * 128 + kk * 32 + h * 16);
#pragma unroll
                for (int sub = 0; sub < 2; ++sub) {
                    f32x16 s;
#pragma unroll
                    for (int i = 0; i < 16; ++i) s[i] = -mrun;
#pragma unroll
                    for (int kk = 0; kk < 4; ++kk) s = mfma32(ka[kk], qf[kk], s);
                    s16x4 vlo[8], vhi[8];
#pragma unroll
                    for (int vt = 0; vt < 4; ++vt) { const LAS unsigned char* vp = vb + (32 * vt + r) * AV_STRIDE + (32 * sub + 4 * h) * 2;
                        vlo[2 * vt] = *(const LAS s16x4*)vp; vhi[2 * vt] = *(const LAS s16x4*)(vp + 16); vlo[2 * vt + 1] = *(const LAS s16x4*)(vp + 32); vhi[2 * vt + 1] = *(const LAS s16x4*)(vp + 48); }
                    if (sub == 0) {
#pragma unroll
                        for (int kk = 0; kk < 4; ++kk) ka[kk] = *(const LAS bf16x8*)(kb + (32 + r) * AK_STRIDE + c * 128 + kk * 32 + h * 16);
                    }
                    __builtin_amdgcn_sched_barrier(0);
                    float mx = fmaxf(fmaxf(s[0], s[1]), s[2]);
#pragma unroll
                    for (int i = 3; i < 15; i += 2) mx = fmaxf(fmaxf(mx, s[i]), s[i + 1]);
                    mx = fmaxf(mx, s[15]);
                    const bool first = (t == 0 && sub == 0);
                    if (__any(mx > 8.0f) || first) {
                        const float mf = fmaxf(mx, __shfl_xor(mx, 32));
                        const float delta = first ? mf : fmaxf(mf, 0.f);
                        const float alpha = first ? 1.0f : __builtin_amdgcn_exp2f(-delta);
                        mrun += delta; lrun *= alpha;
#pragma unroll
                        for (int i = 0; i < 16; ++i) s[i] -= delta;
#pragma unroll
                        for (int vt = 0; vt < 4; ++vt)
#pragma unroll
                            for (int i = 0; i < 16; ++i) O[vt][i] *= alpha;
                    }
                    float ps0 = 0.f, ps1 = 0.f, ps2 = 0.f, ps3 = 0.f;
#pragma unroll
                    for (int i = 0; i < 16; i += 4) { s[i] = __builtin_amdgcn_exp2f(s[i]); s[i + 1] = __builtin_amdgcn_exp2f(s[i + 1]); s[i + 2] = __builtin_amdgcn_exp2f(s[i + 2]); s[i + 3] = __builtin_amdgcn_exp2f(s[i + 3]);
                        ps0 += s[i]; ps1 += s[i + 1]; ps2 += s[i + 2]; ps3 += s[i + 3]; }
                    lrun += (ps0 + ps1) + (ps2 + ps3);
                    const bf16x8 pf0 = pack8(s, 0), pf1 = pack8(s, 1);
#pragma unroll
                    for (int vt = 0; vt < 4; ++vt) {
                        O[vt] = mfma32(cat4(vlo[2 * vt], vhi[2 * vt]), pf0, O[vt]);
                        O[vt] = mfma32(cat4(vlo[2 * vt + 1], vhi[2 * vt + 1]), pf1, O[vt]);
                    }
                }
            }
            if (t + 1 < nt) ATT_STORE((t + 1) & 1);
            __syncthreads();
        }
#undef ATT_LOAD
#undef ATT_STORE
        LAS float* ex = (LAS float*)lds;
        { const float lt = lrun + __shfl_xor(lrun, 32); const float il = __builtin_amdgcn_rcpf(lt);
#pragma unroll
          for (int vt = 0; vt < 4; ++vt)
#pragma unroll
              for (int i = 0; i < 16; ++i) O[vt][i] *= il; }
        if (c == 1) {
#pragma unroll
            for (int vt = 0; vt < 4; ++vt)
#pragma unroll
                for (int i = 0; i < 16; ++i) { const int v = 32 * vt + (i & 3) + 8 * (i >> 2) + 4 * h; ex[(qg * 128 + v) * 32 + r] = O[vt][i]; }
        }
        __syncthreads();
        if (c == 0) {
            float ssq = 0.f;
#pragma unroll
            for (int vt = 0; vt < 4; ++vt)
#pragma unroll
                for (int i = 0; i < 16; ++i) { const int v = 32 * vt + (i & 3) + 8 * (i >> 2) + 4 * h; const float o = O[vt][i] - lam * ex[(qg * 128 + v) * 32 + r]; O[vt][i] = o; ssq += o * o; }
            ssq += __shfl_xor(ssq, 32);
            const float rstd = __builtin_amdgcn_rsqf(ssq * (1.0f / 128.0f) + EPS) * OUTSC;
            bf16* orow = OB + (size_t)qrow * D + head * 128;
#pragma unroll
            for (int vt = 0; vt < 4; ++vt)
#pragma unroll
                for (int g4 = 0; g4 < 4; ++g4) { const int v = 32 * vt + 8 * g4 + 4 * h; const f32x4 gn = *(const f32x4*)(subln + v);
                    u32x2 wv; wv.x = cvtpk(O[vt][4 * g4] * rstd * gn.x, O[vt][4 * g4 + 1] * rstd * gn.y); wv.y = cvtpk(O[vt][4 * g4 + 2] * rstd * gn.z, O[vt][4 * g4 + 3] * rstd * gn.w);
                    *(u32x2*)(orow + v) = wv; }
        }
        __syncthreads();
    }
}

constexpr int SQ_STRIDE = 272, ST_STRIDE = 80;
constexpr int SRAW_OFF = 77824, SRAW_BYTES = 24576;
constexpr int SG_QH = 0, SG_KH = 32 * SQ_STRIDE, SG_KT = 2 * 32 * SQ_STRIDE, SG_VT = SG_KT + 128 * ST_STRIDE, SG_DL = SG_VT + 128 * ST_STRIDE, SG_SSQ = SG_DL + 512, SG_BYTES = SG_SSQ + 512;
DI void scan_phase(int ph, LAS unsigned char* lds, const bf16* HQ, const bf16* HI, const bf16* HG, const bf16* LF, const bf16* LB, float* OS, bf16* OB,
                   const float* st_in, float* st_out, const float* gnorm, float* SLOC, float* DSEG) {
    int tid_ = threadIdx.x; asm volatile("" : "+v"(tid_));
    const int tid = tid_, lane = tid & 63, w = __builtin_amdgcn_readfirstlane(tid >> 6), r = lane & 31, h = lane >> 5;
    const int g = w >> 2, ws = w & 3, tg = tid & 255, kc = tg >> 1, th = tg & 1;
    LAS unsigned char* gl = lds + g * SG_BYTES;
    const bf16* LG = g ? LB : LF;
    const int nitems = ph == 0 ? 384 : 256;
    for (int v = blockIdx.x; v < nitems; v += gridDim.x) {
        bool full, sample; int row0, head, b, seg = 0, p = 0;
        if (ph == 0 && v >= 128 && v < 256) { const int pi = v - 128; b = pi >> 3; head = pi & 7; row0 = b * 256; full = true; sample = false; }
        else { p = ph == 0 ? (v < 128 ? v : v - 128) : v; b = p >> 6; seg = (p >> 3) & 7; head = p & 7; row0 = TP + b * 2048 + seg * 256; full = (ph != 0); sample = true; }
        const size_t cbase = (size_t)row0 * D + head * 128;
        const bf16* LGb = LG + cbase; const bf16* HQb = HQ + cbase; const bf16* HIb = HI + cbase;
        f32x16 S[4];
#pragma unroll
        for (int Tt = 0; Tt < 4; ++Tt)
#pragma unroll
            for (int i = 0; i < 16; ++i) S[Tt][i] = 0.f;
        if (full && sample) {
            const float* sp = st_in + (size_t)((b * 2 + g) * 8 + head) * 16384 + 32 * ws + r;
#pragma unroll
            for (int Tt = 0; Tt < 4; ++Tt)
#pragma unroll
                for (int i = 0; i < 16; ++i) S[Tt][i] = sp[(32 * Tt + (i & 3) + 8 * (i >> 2) + 4 * h) * 128];
            const int nseg = g ? 7 - seg : seg;
            for (int q = 0; q < nseg; ++q) {
                const int jj = g ? 7 - q : q, pj = (b * 8 + jj) * 8 + head;
                const float* dp = DSEG + (size_t)(pj * 2 + g) * 128 + 4 * h; const float* lp = SLOC + (size_t)(pj * 2 + g) * 16384 + 32 * ws + r;
#pragma unroll
                for (int Tt = 0; Tt < 4; ++Tt)
#pragma unroll
                    for (int g4 = 0; g4 < 4; ++g4) { const f32x4 dl = *(const f32x4*)(dp + 32 * Tt + 8 * g4); const float* lq = lp + (size_t)(32 * Tt + 8 * g4 + 4 * h) * 128;
                        S[Tt][4 * g4] = S[Tt][4 * g4] * dl.x + lq[0]; S[Tt][4 * g4 + 1] = S[Tt][4 * g4 + 1] * dl.y + lq[128];
                        S[Tt][4 * g4 + 2] = S[Tt][4 * g4 + 2] * dl.z + lq[256]; S[Tt][4 * g4 + 3] = S[Tt][4 * g4 + 3] * dl.w + lq[384]; }
            }
        }
        LAS unsigned char* raw = lds + SRAW_OFF + g * SRAW_BYTES;
        u32x4 rg[6];
#define SC_TOK(cc, t) (g ? (255 - (32 * (cc) + (t))) : (32 * (cc) + (t)))
#define SC_GLOAD(cc) do { _Pragma("unroll") for (int _i = 0; _i < 2; ++_i) { const int _id = tg + 256 * _i; const unsigned _o = (unsigned)(SC_TOK(cc, _id >> 4) * D + (_id & 15) * 8); \
            rg[_i] = *(const u32x4*)(LGb + _o); rg[2 + _i] = *(const u32x4*)(HIb + _o); if (full) rg[4 + _i] = *(const u32x4*)(HQb + _o); } } while (0)
#define SC_LSTORE() do { _Pragma("unroll") for (int _i = 0; _i < 2; ++_i) { const int _id = tg + 256 * _i; \
            *(LAS u32x4*)(raw + _id * 16) = rg[_i]; *(LAS u32x4*)(raw + 8192 + _id * 16) = rg[2 + _i]; if (full) *(LAS u32x4*)(raw + 16384 + _id * 16) = rg[4 + _i]; } } while (0)
#pragma unroll
        for (int t = 0; t < 6; ++t) rg[t] = (u32x4){0u, 0u, 0u, 0u};
        SC_GLOAD(0); SC_LSTORE();
        __syncthreads();
        float bsum = 0.f;
        for (int s = 0; s < 8; ++s) {
            float la[16]; float suma = 0.f;
#pragma unroll
            for (int t = 0; t < 16; ++t) { la[t] = bf2f(*(const LAS unsigned short*)(raw + (16 * th + t) * 256 + kc * 2)); suma += la[t]; }
            const float sumo = __shfl_xor(suma, 1), blast = suma + sumo;
            bsum += blast;
            float bb = th ? sumo : 0.f;
            unsigned ktp[8];
#pragma unroll
            for (int tt = 0; tt < 16; tt += 2) {
                float ktv[2];
#pragma unroll
                for (int e = 0; e < 2; ++e) {
                    const float lft = la[tt + e];
                    bb += lft;
                    const float kk = 1.0f - fexp(lft);
                    ktv[e] = kk * fexp(blast - bb);
                    if (full) {
                        const float qh = bf2f(*(const LAS unsigned short*)(raw + 16384 + (16 * th + tt + e) * 256 + kc * 2)) * fexp(fmaxf(bb, -80.0f)), kh = kk * fexp(fminf(-bb, 80.0f));
                        const int t = 16 * th + tt + e;
                        *(LAS unsigned short*)(gl + SG_QH + t * SQ_STRIDE + kc * 2) = (unsigned short)(cvtpk(qh, 0.f) & 0xffffu);
                        *(LAS unsigned short*)(gl + SG_KH + t * SQ_STRIDE + kc * 2) = (unsigned short)(cvtpk(kh, 0.f) & 0xffffu);
                    }
                }
                ktp[tt >> 1] = cvtpk(ktv[0], ktv[1]);
            }
            { u32x4 a, bq; a.x = ktp[0]; a.y = ktp[1]; a.z = ktp[2]; a.w = ktp[3]; bq.x = ktp[4]; bq.y = ktp[5]; bq.z = ktp[6]; bq.w = ktp[7];
              *(LAS u32x4*)(gl + SG_KT + kc * ST_STRIDE + th * 32) = a; *(LAS u32x4*)(gl + SG_KT + kc * ST_STRIDE + th * 32 + 16) = bq;
              unsigned iv2[8];
#pragma unroll
              for (int q = 0; q < 8; ++q) iv2[q] = (unsigned)*(const LAS unsigned short*)(raw + 8192 + (16 * th + 2 * q) * 256 + kc * 2) | ((unsigned)*(const LAS unsigned short*)(raw + 8192 + (16 * th + 2 * q + 1) * 256 + kc * 2) << 16);
              a.x = iv2[0]; a.y = iv2[1]; a.z = iv2[2]; a.w = iv2[3]; bq.x = iv2[4]; bq.y = iv2[5]; bq.z = iv2[6]; bq.w = iv2[7];
              *(LAS u32x4*)(gl + SG_VT + kc * ST_STRIDE + th * 32) = a; *(LAS u32x4*)(gl + SG_VT + kc * ST_STRIDE + th * 32 + 16) = bq; }
            if (th == 0) *(LAS float*)(gl + SG_DL + kc * 4) = fexp(blast);
            __syncthreads();
            if (s + 1 < 8) SC_GLOAD(s + 1);
            const size_t obase = cbase + (size_t)SC_TOK(s, r) * D + 32 * ws + 4 * h;
            const bool second = (s >= 4);
            f32x16 o;
            f32x4 pv[4]; u32x2 gv[4];
            if (full) {
                if (second) {
#pragma unroll
                    for (int g4 = 0; g4 < 4; ++g4) { pv[g4] = *(const f32x4*)(OS + obase + 8 * g4); gv[g4] = *(const u32x2*)(HG + obase + 8 * g4); }
                }
                f32x16 at, at2;
#pragma unroll
                for (int i = 0; i < 16; ++i) { at[i] = 0.f; at2[i] = 0.f; }
#pragma unroll
                for (int kk = 0; kk < 8; kk += 2) {
                    const bf16x8 ka = *(const LAS bf16x8*)(gl + SG_KH + r * SQ_STRIDE + kk * 32 + h * 16), qb = *(const LAS bf16x8*)(gl + SG_QH + r * SQ_STRIDE + kk * 32 + h * 16);
                    const bf16x8 ka2 = *(const LAS bf16x8*)(gl + SG_KH + r * SQ_STRIDE + kk * 32 + 32 + h * 16), qb2 = *(const LAS bf16x8*)(gl + SG_QH + r * SQ_STRIDE + kk * 32 + 32 + h * 16);
                    at = mfma32(ka, qb, at); at2 = mfma32(ka2, qb2, at2); }
#pragma unroll
                for (int i = 0; i < 16; ++i) { const int srow = (i & 3) + 8 * (i >> 2) + 4 * h; at[i] = srow > r ? 0.f : at[i] + at2[i]; }
#pragma unroll
                for (int i = 0; i < 16; ++i) o[i] = 0.f;
#pragma unroll
                for (int jj = 0; jj < 2; ++jj) { const LAS unsigned char* vp = gl + SG_VT + (32 * ws + r) * ST_STRIDE + (16 * jj + 4 * h) * 2;
                    o = mfma32(cat4(*(const LAS s16x4*)vp, *(const LAS s16x4*)(vp + 16)), pack8(at, jj), o); }
#pragma unroll
                for (int Tt = 0; Tt < 4; ++Tt)
#pragma unroll
                    for (int jj = 0; jj < 2; ++jj) { const LAS unsigned char* qp = gl + SG_QH + r * SQ_STRIDE + (32 * Tt + 16 * jj + 4 * h) * 2;
                        o = mfma32(pack8(S[Tt], jj), cat4(*(const LAS s16x4*)qp, *(const LAS s16x4*)(qp + 16)), o); }
            }
#pragma unroll
            for (int Tt = 0; Tt < 4; ++Tt) {
#pragma unroll
                for (int g4 = 0; g4 < 4; ++g4) { const f32x4 dl = *(const LAS f32x4*)(gl + SG_DL + (32 * Tt + 8 * g4 + 4 * h) * 4);
                    S[Tt][4 * g4] *= dl.x; S[Tt][4 * g4 + 1] *= dl.y; S[Tt][4 * g4 + 2] *= dl.z; S[Tt][4 * g4 + 3] *= dl.w; }
#pragma unroll
                for (int jj = 0; jj < 2; ++jj) { const bf16x8 ka = *(const LAS bf16x8*)(gl + SG_KT + (32 * Tt + r) * ST_STRIDE + (16 * jj + 8 * h) * 2), vbq = *(const LAS bf16x8*)(gl + SG_VT + (32 * ws + r) * ST_STRIDE + (16 * jj + 8 * h) * 2);
                    S[Tt] = mfma32(ka, vbq, S[Tt]); }
            }
            if (full) {
                if (!second) {
#pragma unroll
                    for (int g4 = 0; g4 < 4; ++g4) { f32x4 vv; vv.x = o[4 * g4]; vv.y = o[4 * g4 + 1]; vv.z = o[4 * g4 + 2]; vv.w = o[4 * g4 + 3]; *(f32x4*)(OS + obase + 8 * g4) = vv; }
                    if (s == 3) asm volatile("s_waitcnt vmcnt(0)" ::: "memory");
                } else {
                    float ssq = 0.f;
#pragma unroll
                    for (int g4 = 0; g4 < 4; ++g4) { const f32x4 pp = pv[g4];
                        o[4 * g4] += pp.x; o[4 * g4 + 1] += pp.y; o[4 * g4 + 2] += pp.z; o[4 * g4 + 3] += pp.w;
                        ssq += (o[4 * g4] * o[4 * g4] + o[4 * g4 + 1] * o[4 * g4 + 1]) + (o[4 * g4 + 2] * o[4 * g4 + 2] + o[4 * g4 + 3] * o[4 * g4 + 3]); }
                    ssq += __shfl_xor(ssq, 32);
                    if (h == 0) *(LAS float*)(gl + SG_SSQ + (r * 4 + ws) * 4) = ssq;
                    __syncthreads();
                    const f32x4 sq = *(const LAS f32x4*)(gl + SG_SSQ + r * 16);
                    const float rstd = __builtin_amdgcn_rsqf(((sq.x + sq.y) + (sq.z + sq.w)) * (1.0f / 128.0f) + EPS);
#pragma unroll
                    for (int g4 = 0; g4 < 4; ++g4) { const u32x2 gg = gv[g4]; const f32x4 gn = *(const f32x4*)(gnorm + 32 * ws + 4 * h + 8 * g4);
                        const float g0 = __uint_as_float(gg.x << 16), g1 = __uint_as_float(gg.x & 0xffff0000u), g2 = __uint_as_float(gg.y << 16), g3 = __uint_as_float(gg.y & 0xffff0000u);
                        u32x2 wv; wv.x = cvtpk(o[4 * g4] * rstd * gn.x * fsigmoid(g0), o[4 * g4 + 1] * rstd * gn.y * fsigmoid(g1));
                        wv.y = cvtpk(o[4 * g4 + 2] * rstd * gn.z * fsigmoid(g2), o[4 * g4 + 3] * rstd * gn.w * fsigmoid(g3));
                        *(u32x2*)(OB + obase + 8 * g4) = wv; }
                }
            }
            if (s + 1 < 8) SC_LSTORE();
            __syncthreads();
        }
#undef SC_GLOAD
#undef SC_LSTORE
#undef SC_TOK
        if (!full) {
            float* sp = SLOC + (size_t)(p * 2 + g) * 16384 + 32 * ws + r;
#pragma unroll
            for (int Tt = 0; Tt < 4; ++Tt)
#pragma unroll
                for (int i = 0; i < 16; ++i) sp[(32 * Tt + (i & 3) + 8 * (i >> 2) + 4 * h) * 128] = S[Tt][i];
            if (th == 0 && ws == 0) { }
            if (th == 0) DSEG[(size_t)(p * 2 + g) * 128 + kc] = fexp(bsum);
        } else if (!sample) {
            float* sp = st_out + (size_t)((b * 2 + g) * 8 + head) * 16384 + 32 * ws + r;
#pragma unroll
            for (int Tt = 0; Tt < 4; ++Tt)
#pragma unroll
                for (int i = 0; i < 16; ++i) sp[(32 * Tt + (i & 3) + 8 * (i >> 2) + 4 * h) * 128] = S[Tt][i];
        }
    }
}

#define GAS __attribute__((address_space(1)))
#define XB_TMO      128
#define XB_XCNT(j)  (256  + 64 * (j))
#define XB_XSUB(j)  (1280 + 64 * (j))
#define XB_XGEN(j)  (2304 + 64 * (j))
#define XB_TOP      3328
#define XB_TOPGEN   3392
#define XCD_BAR_WORDS 3456
#define XB_SPIN_CAP (1u << 18)

__device__ __forceinline__ unsigned xb_ld(unsigned* p)              { return __hip_atomic_load(p, __ATOMIC_RELAXED, __HIP_MEMORY_SCOPE_AGENT); }
__device__ __forceinline__ unsigned xb_add(unsigned* p, unsigned v) { return __hip_atomic_fetch_add(p, v, __ATOMIC_RELAXED, __HIP_MEMORY_SCOPE_AGENT); }
__device__ __forceinline__ unsigned xb_xcc_id() { return (unsigned)__builtin_amdgcn_s_getreg((3 << 11) | 20) & 0xFu; }
#define XB_SPIN(cond, bar) do { unsigned _sp = 0; while (cond) { __builtin_amdgcn_s_sleep(1); \
    if ((++_sp & 255u) == 0u) { if (xb_ld(&(bar)[XB_TMO])) break; if (_sp > XB_SPIN_CAP) { atomicAdd(&(bar)[XB_TMO], 1u); break; } } } } while (0)

struct XcdBarrier {
    unsigned* bar; unsigned x;
    volatile LAS unsigned* st;
};

__device__ __forceinline__ XcdBarrier xcd_barrier_post(unsigned* bar, volatile LAS unsigned* st) {
    XcdBarrier b; b.bar = bar; b.x = xb_xcc_id(); b.st = st;
    if (threadIdx.x == 0) (void)xb_add(&bar[XB_XCNT(b.x)], 1u);
    return b;
}
__device__ __forceinline__ void xcd_barrier_complete(unsigned* bar, unsigned x, unsigned& nloc, unsigned& nx) {
    const unsigned G = gridDim.x * gridDim.y * gridDim.z;
    unsigned sum, cnt, mine, sp = 0u;
    for (;;) {
        sum = 0u; cnt = 0u; mine = 0u;
#pragma unroll
        for (unsigned j = 0; j < 16; ++j) { const unsigned c = xb_ld(&bar[XB_XCNT(j)]); sum += c; cnt += (c > 0u) ? 1u : 0u; mine = (j == x) ? c : mine; }
        if (sum == G) break;
        __builtin_amdgcn_s_sleep(1);
        if ((++sp & 255u) == 0u) { if (xb_ld(&bar[XB_TMO])) break; if (sp > XB_SPIN_CAP) { atomicAdd(&bar[XB_TMO], 1u); break; } }
    }
    nloc = mine > 0u ? mine : 1u; nx = cnt > 0u ? cnt : 1u;
}

__device__ __forceinline__ void xcd_barrier(const XcdBarrier& b) {
    asm volatile("s_waitcnt vmcnt(0)" ::: "memory");
    __syncthreads();
    if (threadIdx.x == 0) {
        unsigned* bar = b.bar;
        __builtin_amdgcn_s_waitcnt(0);
        unsigned nloc = b.st[0], nx = b.st[1];
        if (nloc == 0u) { xcd_barrier_complete(bar, b.x, nloc, nx); b.st[0] = nloc; b.st[1] = nx; }
        const unsigned old = xb_add(&bar[XB_XSUB(b.x)], 1u);
        const unsigned gen = old / nloc;
        if (old + 1u == (gen + 1u) * nloc) {
            __builtin_amdgcn_fence(__ATOMIC_RELEASE, "agent");
            asm volatile("s_waitcnt vmcnt(0)" ::: "memory");
            const unsigned og = xb_add(&bar[XB_TOP], 1u);
            const unsigned tg = og / nx;
            if (og + 1u == (tg + 1u) * nx) xb_add(&bar[XB_TOPGEN], 1u);
            else XB_SPIN(xb_ld(&bar[XB_TOPGEN]) == tg, bar);
            __builtin_amdgcn_fence(__ATOMIC_ACQUIRE, "agent");
            xb_add(&bar[XB_XGEN(b.x)], 1u);
            asm volatile("s_waitcnt vmcnt(0)" ::: "memory");
        } else {
            XB_SPIN(xb_ld(&bar[XB_XGEN(b.x)]) == gen, bar);
            __builtin_amdgcn_fence(__ATOMIC_ACQUIRE, "agent");
            asm volatile("s_waitcnt vmcnt(0)" ::: "memory");
        }
    }
    __syncthreads();
}


struct Args {
    const float *xp, *xs, *cache_k, *cache_v, *state, *c, *cctx, *wmod, *bmod, *normg, *ffn_in, *ffn_out, *attn_in, *attn_out, *attn_lam, *attn_subln, *hgrn_in, *hgrn_out, *hgrn_lb, *hgrn_gn;
    float* out; unsigned char* ws;
};
constexpr int LDS_BYTES = 147456, MISC_OFF = 146432, STAMP_OFF = MISC_OFF + 256;
constexpr size_t OUT_NCK = (size_t)T * D, OUT_NCV = OUT_NCK + (size_t)TP * D, OUT_ST = OUT_NCV + (size_t)TP * D;

typedef const __attribute__((address_space(4))) Args* KArgs;
constexpr int CV_FIN = 16 * 88, CV_FOUT = 44 * 16, CV_AIN = 16 * 48, CV_SQ = 16 * 16, CV_HIN = 16 * 80;
constexpr int CV0 = 0, CV1 = CV0 + CV_FIN  , CV2 = CV1 + CV_FOUT  , CV3 = CV2 + CV_AIN  , CV4 = CV3 + CV_SQ  , CV5 = CV4 + CV_FIN  , CV6 = CV5 + CV_FOUT  ,
              CV7 = CV6 + CV_FIN  , CV8 = CV7 + CV_FOUT  , CV9 = CV8 + CV_SQ  , CV10 = CV9 + CV_HIN  , CV11 = CV10 + CV_FIN  , CV12 = CV11 + CV_FOUT  ;
DI int cv_seg_lo(int sg) { return sg == 0 ? CV0 : sg == 1 ? CV1 : sg == 2 ? CV3 : sg == 3 ? CV5 : sg == 4 ? CV7 : sg == 5 ? CV9 : sg == 6 ? CV11 : CV10; }
DI int cv_seg_hi(int sg) { return sg == 0 ? CV1 : sg == 1 ? CV3 : sg == 2 ? CV5 : sg == 3 ? CV7 : sg == 4 ? CV9 : sg == 5 ? CV10 : sg == 6 ? CV12 : CV11; }
DI void convert_range(KArgs a, LAS unsigned char* lds, int lo, int hi, int wrank, int nw, int wave, int lane) {
    unsigned char* ws = a->ws;
    LAS float* scr = (LAS float*)(lds + wave * 16640);
    for (int it = lo + wrank; it < hi; it += nw) {
        if (it < CV1) transpose_item(a->ffn_in, D, 2 * FH, (bf16*)(ws + WS_FIN00), true, scr, it - CV0, lane);
        else if (it < CV2) transpose_item(a->ffn_out, FH, D, (bf16*)(ws + WS_FOUT00), false, scr, it - CV1, lane);
        else if (it < CV3) transpose_item(a->attn_in, D, 3 * D, (bf16*)(ws + WS_AIN), false, scr, it - CV2, lane);
        else if (it < CV4) transpose_item(a->attn_out, D, D, (bf16*)(ws + WS_AOUT), false, scr, it - CV3, lane);
        else if (it < CV5) transpose_item(a->ffn_in + (size_t)1 * D * (2 * FH), D, 2 * FH, (bf16*)(ws + WS_FIN01), true, scr, it - CV4, lane);
        else if (it < CV6) transpose_item(a->ffn_out + (size_t)1 * FH * D, FH, D, (bf16*)(ws + WS_FOUT01), false, scr, it - CV5, lane);
        else if (it < CV7) transpose_item(a->ffn_in + (size_t)2 * D * (2 * FH), D, 2 * FH, (bf16*)(ws + WS_FIN10), true, scr, it - CV6, lane);
        else if (it < CV8) transpose_item(a->ffn_out + (size_t)2 * FH * D, FH, D, (bf16*)(ws + WS_FOUT10), false, scr, it - CV7, lane);
        else if (it < CV9) transpose_item(a->hgrn_out, D, D, (bf16*)(ws + WS_HOUT), false, scr, it - CV8, lane);
        else if (it < CV10) transpose_item(a->hgrn_in, D, 5 * D, (bf16*)(ws + WS_HIN), false, scr, it - CV9, lane);
        else if (it < CV11) transpose_item(a->ffn_in + (size_t)3 * D * (2 * FH), D, 2 * FH, (bf16*)(ws + WS_FIN11), true, scr, it - CV10, lane);
        else transpose_item(a->ffn_out + (size_t)3 * FH * D, FH, D, (bf16*)(ws + WS_FOUT11), false, scr, it - CV11, lane);
    }
}
#define CONVERT_IDLE(nwg_, sg_) do { const int _sg = (sg_); if (_sg >= 0) { const int _rem = (nwg_) % G, _c = (int)blockIdx.x; \
        if (_rem == 0 || _c >= _rem) { const int _tid = TIDV(), _wave = __builtin_amdgcn_readfirstlane(_tid >> 6); \
            convert_range(KA(), lds, cv_seg_lo(_sg), cv_seg_hi(_sg), (_rem == 0 ? _c : _c - _rem) * 8 + _wave, (_rem == 0 ? G : G - _rem) * 8, _wave, _tid & 63); } } } while (0)
#define KA() ({ KArgs _p = (KArgs)__builtin_amdgcn_kernarg_segment_ptr(); asm volatile("" : "+s"(_p)); _p; })
__global__ void __launch_bounds__(512) fwd_kernel(Args a_unused) {
    extern __shared__ __attribute__((aligned(16))) unsigned char lds_raw[];
    LAS unsigned char* lds = (LAS unsigned char*)lds_raw;
    cg::grid_group grid = cg::this_grid();
    const int G = gridDim.x;
    if (threadIdx.x < 64) ((volatile LAS unsigned*)(lds + MISC_OFF))[threadIdx.x] = 0u;
    __syncthreads();
    int nst = 0; STAMP();
    const XcdBarrier xbar = xcd_barrier_post((unsigned*)KA()->ws, (volatile LAS unsigned*)(lds + MISC_OFF) + 8);
#define TIDV() ({ int _t = threadIdx.x; asm volatile("" : "+v"(_t)); _t; })

    for (int rep = 0; rep < REP_P0; ++rep) {
        __syncthreads();
        KArgs a = KA(); unsigned char* ws = a->ws; float* MOD = (float*)(ws + WS_MOD);
        const int tid = TIDV(), lane = tid & 63, wave = __builtin_amdgcn_readfirstlane(tid >> 6), gw = blockIdx.x * 8 + wave, NGW = G * 8;
        LAS float* sv = (LAS float*)lds; LAS float* red = (LAS float*)(lds + 20480);
        if (blockIdx.x < 72) {
            for (int i = tid; i < 5 * D; i += 512) { const int mi = i >> 10, d = i & 1023; const float x = mi ? a->c[(mi - 1) * D + d] : a->cctx[d]; sv[i] = x * fsigmoid(x); }
            __syncthreads();
            for (int unit = blockIdx.x; unit < 72; unit += G) {
                const int l = unit / 36, cb = unit % 36, col = cb * 256 + 4 * lane;
                const float* wp = a->wmod + (size_t)l * D * NMODE + (size_t)(128 * wave) * NMODE + col;
                f32x4 ac[5];
#pragma unroll
                for (int m = 0; m < 5; ++m) ac[m] = (f32x4){0.f, 0.f, 0.f, 0.f};
#pragma unroll 16
                for (int d = 0; d < 128; ++d) { const f32x4 wv = __builtin_nontemporal_load((const f32x4*)(wp + (size_t)d * NMODE)); const int dd = 128 * wave + d;
#pragma unroll
                    for (int m = 0; m < 5; ++m) ac[m] += wv * sv[m * D + dd]; }
#pragma unroll
                for (int m = 0; m < 5; ++m) *(LAS f32x4*)(red + (wave * 5 + m) * 256 + 4 * lane) = ac[m];
                __syncthreads();
                for (int o = tid; o < 5 * 256; o += 512) { const int mi = o >> 8, cl = o & 255; float sacc = 0.f;
#pragma unroll
                    for (int ww = 0; ww < 8; ++ww) sacc += red[(ww * 5 + mi) * 256 + cl];
                    MOD[(size_t)(l * 5 + mi) * NMODE + cb * 256 + cl] = sacc + a->bmod[l * NMODE + cb * 256 + cl]; }
                __syncthreads();
            }
        }
        if (G > 144) { if (blockIdx.x >= 72) convert_range(a, lds, cv_seg_lo(0), cv_seg_hi(0), gw - 72 * 8, NGW - 72 * 8, wave, lane); }
        else convert_range(a, lds, cv_seg_lo(0), cv_seg_hi(0), gw, NGW, wave, lane);
    }
    if (G == 0x7fffff) grid.sync();
    xcd_barrier(xbar);
    STAMP();
#define NORM(YY, HH, lpost, jpost, gpost_i, resw, lpre, jpre, gpre_i) NORMX(false, YY, HH, lpost, jpost, gpost_i, resw, lpre, jpre, gpre_i)
#define NORMX(FIRST, YY, HH, lpost, jpost, gpost_i, resw, lpre, jpre, gpre_i) do { for (int _nr = 0; _nr < REP_NORM; ++_nr) { KArgs a = KA(); unsigned char* ws = a->ws; float* MOD = (float*)(ws + WS_MOD); float* X = a->out; \
        const int tid = TIDV(), lane = tid & 63, wave = __builtin_amdgcn_readfirstlane(tid >> 6); \
        norm_phase(((FIRST) && _nr == 0) ? a->xp : X, ((FIRST) && _nr == 0) ? a->xs : X + (size_t)TP * D, (YY) ? (const bf16*)(ws + WS_Y) : nullptr, X, (HH) ? (bf16*)(ws + WS_H) : nullptr, MOD + (size_t)(lpost) * 5 * NMODE, (jpost), a->normg + (size_t)(gpost_i) * D, _nr ? 0.f : (resw), \
                   MOD + (size_t)(lpre) * 5 * NMODE, (jpre), a->normg + (size_t)(gpre_i) * D, blockIdx.x * 8 + wave, G * 8, lane); } } while (0)
    { KArgs a = KA(); unsigned char* ws = a->ws; float* MOD = (float*)(ws + WS_MOD);
      const int tid = TIDV(), lane = tid & 63, wave = __builtin_amdgcn_readfirstlane(tid >> 6);
      norm_phase(a->xp, a->xs, nullptr, nullptr, (bf16*)(ws + WS_H), MOD, 0, a->normg, 0.f, MOD, 0, a->normg, blockIdx.x * 8 + wave, G * 8, lane); }
    GSYNC();
    for (int l = 0; l < 2; ++l) {
        for (int half = 0; half < 2; ++half) {
            for (int rep = 0; rep < REP_FIN; ++rep) {
                unsigned char* ws = KA()->ws;
                const bf16* Wt = (const bf16*)(ws + (l == 0 ? (half ? WS_FIN01 : WS_FIN00) : (half ? WS_FIN11 : WS_FIN10)));
                pg8::Gemm g{(const bf16*)(ws + WS_H), Wt, T, 2 * FH, D}; pg8::StaticOrder S; S.init(T, 2 * FH, G, (int)blockIdx.x);
                EpiSwiglu E{(bf16*)(ws + WS_ACT)};
                pg8::gemm_phase<EpiSwiglu, pg8::StaticOrder, true, true>(lds, g, S, E);
                CONVERT_IDLE(48 * 22, l == 0 ? (half == 0 ? 1 : 5) : (half == 0 ? 7 : -1));
            }
            GSYNC();
            for (int rep = 0; rep < REP_FOUT; ++rep) {
                unsigned char* ws = KA()->ws;
                const bf16* Wt = (const bf16*)(ws + (l == 0 ? (half ? WS_FOUT01 : WS_FOUT00) : (half ? WS_FOUT11 : WS_FOUT10)));
                pg8::Gemm g{(const bf16*)(ws + WS_ACT), Wt, T, D, FH}; pg8::StaticOrder S; S.init(T, D, G, (int)blockIdx.x);
                EpiF32 E{(bf16*)(ws + WS_Y)};
                pg8::gemm_phase<EpiF32, pg8::StaticOrder, true, true>(lds, g, S, E);
                CONVERT_IDLE(48 * 4, l == 0 ? (half == 0 ? 2 : 6) : -1);
            }
            GSYNC();
            if (half == 0) NORMX(l == 0, true, true, l, 0, l * 6 + 1, 0.5f, l, 1, l * 6 + 2);
            else if (l == 0) NORM(true, true, 0, 2, 5, 0.5f, 1, 0, 6);
            else NORM(true, false, 1, 2, 11, 0.5f, 1, 0, 6);
            if (half == 1) { if (l == 0) GSYNC(); continue; }
            GSYNC();
            if (l == 0) {
                for (int rep = 0; rep < REP_MIXG; ++rep) { KArgs a = KA(); unsigned char* ws = a->ws;
                  pg8::Gemm g{(const bf16*)(ws + WS_H), (const bf16*)(ws + WS_AIN), T, 3 * D, D}; pg8::StaticOrder S; S.init(T, 3 * D, G, (int)blockIdx.x);
                  EpiQKV E{(bf16*)(ws + WS_Q), (bf16*)(ws + WS_K), (bf16*)(ws + WS_V), a->out + OUT_NCK, a->out + OUT_NCV};
                  pg8::gemm_phase<EpiQKV, pg8::StaticOrder, true, true>(lds, g, S, E);
                  CONVERT_IDLE(48 * 12, 3);
                  const int tid = TIDV();
                  bf16* Kc = (bf16*)(ws + WS_K) + (size_t)T * D; bf16* Vc = (bf16*)(ws + WS_V) + (size_t)T;
                  const float* ck = a->cache_k; const float* cv = a->cache_v;
                  for (int i = blockIdx.x * 512 + tid; i < 1024 * D / 4; i += G * 512) {
                      const f32x4 k4 = *(const f32x4*)(ck + 4 * (size_t)i), v4 = *(const f32x4*)(cv + 4 * (size_t)i);
                      u32x2 kw; kw.x = cvtpk(k4.x, k4.y); kw.y = cvtpk(k4.z, k4.w); const unsigned v01 = cvtpk(v4.x, v4.y), v23 = cvtpk(v4.z, v4.w);
                      *(u32x2*)(Kc + 4 * (size_t)i) = kw;
                      bf16* vt = Vc + (size_t)((4 * i) & 1023) * VTLD + ((4 * i) >> 10);
                      vt[0] = (bf16)(v01 & 0xffffu); vt[VTLD] = (bf16)(v01 >> 16); vt[2 * VTLD] = (bf16)(v23 & 0xffffu); vt[3 * VTLD] = (bf16)(v23 >> 16); }
                }
                GSYNC();
#ifndef NO_ATTN
                for (int rep = 0; rep < REP_ATTN; ++rep) { KArgs a = KA(); unsigned char* ws = a->ws;
                  attn_phase(lds, (const bf16*)(ws + WS_Q), (const bf16*)(ws + WS_K), (const bf16*)(ws + WS_V), (bf16*)(ws + WS_H), a->attn_lam, a->attn_subln); }
#endif
                GSYNC();
                for (int rep = 0; rep < REP_MIXG; ++rep) { unsigned char* ws = KA()->ws;
                  pg8::Gemm g{(const bf16*)(ws + WS_H), (const bf16*)(ws + WS_AOUT), T, D, D}; pg8::StaticOrder S; S.init(T, D, G, (int)blockIdx.x);
                  EpiF32 E{(bf16*)(ws + WS_Y)};
                  pg8::gemm_phase<EpiF32, pg8::StaticOrder, true, true>(lds, g, S, E);
                  CONVERT_IDLE(48 * 4, 4); }
            } else {
                for (int rep = 0; rep < REP_MIXG; ++rep) { KArgs a = KA(); unsigned char* ws = a->ws;
                  pg8::Gemm g{(const bf16*)(ws + WS_H), (const bf16*)(ws + WS_HIN), T, 5 * D, D}; pg8::StaticOrder S; S.init(T, 5 * D, G, (int)blockIdx.x);
                  EpiHgrn E{(bf16*)(ws + WS_HQ), (bf16*)(ws + WS_HI), (bf16*)(ws + WS_HG), (bf16*)(ws + WS_LF), (bf16*)(ws + WS_LB), a->hgrn_lb};
                  pg8::gemm_phase<EpiHgrn, pg8::StaticOrder, true, true>(lds, g, S, E); }
                GSYNC();
#ifndef NO_SCAN
                for (int rep = 0; rep < REP_SCAN; ++rep)
                for (int ph = 0; ph < 2; ++ph) { KArgs a = KA(); unsigned char* ws = a->ws;
                  scan_phase(ph, lds, (const bf16*)(ws + WS_HQ), (const bf16*)(ws + WS_HI), (const bf16*)(ws + WS_HG), (const bf16*)(ws + WS_LF), (const bf16*)(ws + WS_LB), (float*)(ws + WS_Y), (bf16*)(ws + WS_H),
                             a->state, a->out + OUT_ST, a->hgrn_gn, (float*)(ws + WS_SLOC), (float*)(ws + WS_DSEG));
                  if (ph == 0) GSYNC(); }
#endif
                GSYNC();
                for (int rep = 0; rep < REP_MIXG; ++rep) { unsigned char* ws = KA()->ws;
                  pg8::Gemm g{(const bf16*)(ws + WS_H), (const bf16*)(ws + WS_HOUT), T, D, D}; pg8::StaticOrder S; S.init(T, D, G, (int)blockIdx.x);
                  EpiF32 E{(bf16*)(ws + WS_Y)};
                  pg8::gemm_phase<EpiF32, pg8::StaticOrder, true, true>(lds, g, S, E); }
            }
            GSYNC();
            NORM(true, true, l, 1, l * 6 + 3, 1.0f, l, 2, l * 6 + 4);
            GSYNC();
        }
    }
    STAMP();
    if (PROBE_A >= 0 && blockIdx.x == 0 && threadIdx.x == 0) {
        const unsigned long long ta = *(volatile LAS unsigned long long*)(lds + STAMP_OFF + 8 * PROBE_A), tb = *(volatile LAS unsigned long long*)(lds + STAMP_OFF + 8 * PROBE_B);
        const unsigned long long t0 = __builtin_amdgcn_s_memrealtime();
        while (__builtin_amdgcn_s_memrealtime() - t0 < tb - ta) __builtin_amdgcn_s_sleep(8);
    }
}

extern "C" void kernel_launch(void* const* d_in, const int* in_sizes, int n_in, void* d_out, int out_size, void* d_ws, size_t ws_size, hipStream_t stream) {
    static int grid = 0;
    if (!grid) {
        int dev = 0, cus = 0, per = 0;
        (void)hipGetDevice(&dev);
        (void)hipDeviceGetAttribute(&cus, hipDeviceAttributeMultiprocessorCount, dev);
        (void)hipFuncSetAttribute((const void*)fwd_kernel, hipFuncAttributeMaxDynamicSharedMemorySize, LDS_BYTES);
        (void)hipOccupancyMaxActiveBlocksPerMultiprocessor(&per, (const void*)fwd_kernel, 512, LDS_BYTES);
        if (per < 1) fprintf(stderr, "kernel_launch: occupancy query says %d blocks per CU\n", per);
        grid = cus > 0 ? cus : 256;
        if (ws_size < 280u * 1024u * 1024u) fprintf(stderr, "kernel_launch: workspace too small (%zu)\n", ws_size);
    }
    Args a{};
    a.xp = (const float*)d_in[0]; a.xs = (const float*)d_in[1]; a.cache_k = (const float*)d_in[2]; a.cache_v = (const float*)d_in[3]; a.state = (const float*)d_in[4];
    a.c = (const float*)d_in[5]; a.cctx = (const float*)d_in[6]; a.wmod = (const float*)d_in[7]; a.bmod = (const float*)d_in[8]; a.normg = (const float*)d_in[9];
    a.ffn_in = (const float*)d_in[10]; a.ffn_out = (const float*)d_in[11]; a.attn_in = (const float*)d_in[12]; a.attn_out = (const float*)d_in[13];
    a.attn_lam = (const float*)d_in[14]; a.attn_subln = (const float*)d_in[15]; a.hgrn_in = (const float*)d_in[16]; a.hgrn_out = (const float*)d_in[17];
    a.hgrn_lb = (const float*)d_in[18]; a.hgrn_gn = (const float*)d_in[19];
    a.out = (float*)d_out; a.ws = (unsigned char*)d_ws;
    (void)hipMemsetAsync(d_ws, 0, 16384, stream);
    void* args[] = {&a};
    hipError_t e = hipLaunchCooperativeKernel((void*)fwd_kernel, dim3(grid), dim3(512), args, LDS_BYTES, stream);
    if (e != hipSuccess) fprintf(stderr, "kernel_launch: cooperative launch failed: %s (grid %d)\n", hipGetErrorString(e), grid);
}
```
